# Optimizing an MI355X kernel written in HIP

```python
import math
import jax
import jax.numpy as jnp
from jax import lax
import numpy as np

D_MODEL = 1024
BATCH = 16
SEQ = 4096
DEPTH = 2
DEC_BATCH = 16
DEC_SEQ = 2048
PAST_LEN = 128

PLE_DIM = 256
HG_HEADS = 4
HG_DK = 64
HG_DV = 64
HG_WIDTH = HG_HEADS * HG_DV
HG_CHUNK = 64
LRU_WIDTH = D_MODEL // 2
LRU_BLOCKS = 8
LRU_BLOCK = LRU_WIDTH // LRU_BLOCKS
LRU_C = 8.0
CONV_W = 4
DA_HEADS = 4
DA_HEAD_QK = 32
DA_HEAD_V = 2 * DA_HEAD_QK
DA_WIDTH = DA_HEADS * DA_HEAD_V
ROPE_THETA = 500000.0
ROPE_DIM = DA_HEAD_QK // 4
Q_BLOCK = 128
D_MIX = HG_WIDTH + LRU_WIDTH + DA_WIDTH
RMS_EPS = 1e-6
SPLIT_SIZES = (HG_HEADS * HG_DK, HG_HEADS * HG_DK, HG_HEADS * HG_DK, HG_WIDTH, HG_WIDTH,
               LRU_WIDTH, LRU_WIDTH,
               2 * DA_HEADS * DA_HEAD_QK, 2 * DA_HEADS * DA_HEAD_QK, DA_WIDTH, DA_WIDTH)
D_IN = sum(SPLIT_SIZES)

kernel_name = 'hybrid_bidir_hgrn2_rglru_diffattn'


def rmsnorm(x, g):
    x32 = x.astype(jnp.float32)
    y = x32 * lax.rsqrt(jnp.mean(x32 * x32, axis=-1, keepdims=True) + RMS_EPS)
    return (y * g.astype(jnp.float32)).astype(x.dtype)


def hgrn2_scan(q, logf, k, v):
    B, S, H, K = q.shape
    V = v.shape[-1]
    C = HG_CHUNK
    N = S // C

    def chunks(t):
        return t.reshape(B, N, C, H, t.shape[-1]).transpose(1, 0, 3, 2, 4)

    qc, kc, vc = chunks(q), chunks(k), chunks(v)
    cc = jnp.cumsum(chunks(logf), axis=3)
    causal = jnp.tril(jnp.ones((C, C), dtype=bool))[:, :, None]

    def step(state, inp):
        qb, cb, kb, vb = inp
        diff = cb[:, :, :, None, :] - cb[:, :, None, :, :]
        decay = jnp.where(causal, jnp.exp(jnp.where(causal, diff, 0.0)), 0.0)
        scores = jnp.einsum('bhik,bhjk,bhijk->bhij', qb, kb, decay)
        o = (jnp.einsum('bhij,bhjv->bhiv', scores, vb)
             + jnp.einsum('bhik,bhkv->bhiv', qb * jnp.exp(cb), state))
        c_last = cb[:, :, -1:, :]
        new_state = (jnp.exp(c_last)[:, :, 0, :, None] * state
                     + jnp.einsum('bhjk,bhjv->bhkv', kb * jnp.exp(c_last - cb), vb))
        return new_state, o

    init = jnp.zeros((B, H, K, V), dtype=jnp.float32)
    _, o = lax.scan(step, init, (qc, cc, kc, vc))
    return o.transpose(1, 0, 3, 2, 4).reshape(B, S, H, V)


def hgrn2_branch(zq, zf_fwd, zf_bwd, zi, zg, lb, norm_g):
    B, S, _ = zq.shape

    def heads(t):
        return t.astype(jnp.float32).reshape(B, S, HG_HEADS, -1)

    q = jax.nn.silu(heads(zq))
    v = heads(zi)

    def gates(zf, lb_d):
        zf = heads(zf)
        lb_d = lb_d.reshape(HG_HEADS, HG_DK)
        f = lb_d + (1.0 - lb_d) * jax.nn.sigmoid(zf)
        k = (1.0 - lb_d) * jax.nn.sigmoid(-zf)
        return jnp.log(f), k

    logf_f, k_f = gates(zf_fwd, lb[0])
    logf_b, k_b = gates(zf_bwd, lb[1])

    def flip(t):
        return jnp.flip(t, axis=1)

    o = (hgrn2_scan(q, logf_f, k_f, v)
         + flip(hgrn2_scan(flip(q), flip(logf_b), flip(k_b), flip(v))))
    o = rmsnorm(o, norm_g).reshape(B, S, HG_WIDTH)
    return o.astype(zg.dtype) * jax.nn.silu(zg)


def _linear_combine(e1, e2):
    a1, b1 = e1
    a2, b2 = e2
    return a1 * a2, a2 * b1 + b2


def rglru_branch(zx, zg, conv_w, conv_b, wa, ba, wx, bx, lam):
    B, S, W = zx.shape
    left = CONV_W // 2
    xp = jnp.pad(zx, ((0, 0), (left, CONV_W - 1 - left), (0, 0)))
    u = conv_b
    for j in range(CONV_W):
        u = u + xp[:, j:j + S] * conv_w[j]
    u32 = u.astype(jnp.float32)
    ub = u32.reshape(B, S, LRU_BLOCKS, LRU_BLOCK)

    def direction(d, reverse):
        r = jax.nn.sigmoid(jnp.einsum('bsnc,nce->bsne', ub, wa[d].astype(jnp.float32)).reshape(B, S, W)
                           + ba[d].astype(jnp.float32))
        i = jax.nn.sigmoid(jnp.einsum('bsnc,nce->bsne', ub, wx[d].astype(jnp.float32)).reshape(B, S, W)
                           + bx[d].astype(jnp.float32))
        log_a = -LRU_C * jax.nn.softplus(-lam[d].astype(jnp.float32)) * r
        a = jnp.exp(log_a)
        b = jnp.sqrt(-jnp.expm1(2.0 * log_a)) * (i * u32)
        _, h = lax.associative_scan(_linear_combine, (a, b), axis=1, reverse=reverse)
        return h

    h = direction(0, False) + direction(1, True)
    return h.astype(zx.dtype) * jax.nn.silu(zg)


def rope_partial(t, pos):
    half = ROPE_DIM // 2
    inv = ROPE_THETA ** (-jnp.arange(half, dtype=jnp.float32) * 2.0 / ROPE_DIM)
    ang = pos.astype(jnp.float32)[:, None] * inv[None, :]
    cos = jnp.cos(ang)[None, :, None, :]
    sin = jnp.sin(ang)[None, :, None, :]
    t32 = t.astype(jnp.float32)
    t1, t2 = t32[..., :half], t32[..., half:ROPE_DIM]
    rot = jnp.concatenate([t1 * cos - t2 * sin, t2 * cos + t1 * sin], axis=-1)
    return jnp.concatenate([rot.astype(t.dtype), t[..., ROPE_DIM:]], axis=-1)


def diff_attn_branch(zq, zk, zv, zg, lq1, lk1, lq2, lk2, norm_g, lam_init):
    B, S, _ = zq.shape
    pos = jnp.arange(S)
    q = rope_partial(zq.reshape(B, S, 2 * DA_HEADS, DA_HEAD_QK), pos) * (DA_HEAD_QK ** -0.5)
    k = rope_partial(zk.reshape(B, S, 2 * DA_HEADS, DA_HEAD_QK), pos)
    v = zv.reshape(B, S, DA_HEADS, DA_HEAD_V)
    lam = (jnp.exp(jnp.sum(lq1.astype(jnp.float32) * lk1.astype(jnp.float32)))
           - jnp.exp(jnp.sum(lq2.astype(jnp.float32) * lk2.astype(jnp.float32))) + lam_init)
    nb = S // Q_BLOCK
    qb = q.reshape(B, nb, Q_BLOCK, 2 * DA_HEADS, DA_HEAD_QK).transpose(1, 0, 3, 2, 4)
    kt = k.transpose(0, 2, 1, 3)
    vt = v.transpose(0, 2, 1, 3).astype(jnp.float32)

    def block(qblk):
        s = jnp.einsum('bhqd,bhkd->bhqk', qblk, kt).astype(jnp.float32)
        p = jax.nn.softmax(s, axis=-1).reshape(B, DA_HEADS, 2, Q_BLOCK, S)
        w = p[:, :, 0] - lam * p[:, :, 1]
        return jnp.einsum('bhqk,bhkv->bhqv', w, vt)

    o = lax.map(block, qb)
    o = o.transpose(1, 0, 3, 2, 4).reshape(B, S, DA_HEADS, DA_HEAD_V)
    o = rmsnorm(o, norm_g) * (1.0 - lam_init)
    return o.reshape(B, S, DA_WIDTH).astype(zg.dtype) * jax.nn.silu(zg)


def trunk(x, p, norm_g, w_in, w_out, hg_lb, hg_norm, lru_conv_w, lru_conv_b, lru_wa, lru_ba,
          lru_wx, lru_bx, lru_lam, da_lq1, da_lk1, da_lq2, da_lk2, da_norm, ple_w, ple_gate_w,
          final_norm):
    lb_all = jnp.cumsum(jax.nn.softmax(hg_lb.astype(jnp.float32), axis=0), axis=0)
    lb_all = lb_all - lb_all[:1]
    split_at = np.cumsum(SPLIT_SIZES)[:-1].tolist()
    h = x
    for l in range(DEPTH):
        hn = rmsnorm(h, norm_g[l])
        z = hn @ w_in[l]
        (hq, hf_f, hf_b, hi, hg, lx, lg, dq, dk, dv, dg) = jnp.split(z, split_at, axis=-1)
        o_hg = hgrn2_branch(hq, hf_f, hf_b, hi, hg, lb_all[l], hg_norm[l])
        o_lru = rglru_branch(lx, lg, lru_conv_w[l], lru_conv_b[l], lru_wa[l], lru_ba[l],
                             lru_wx[l], lru_bx[l], lru_lam[l])
        lam_init = 0.8 - 0.6 * math.exp(-0.3 * l)
        o_da = diff_attn_branch(dq, dk, dv, dg, da_lq1[l], da_lk1[l], da_lq2[l], da_lk2[l],
                                da_norm[l], lam_init)
        o = jnp.concatenate([o_hg, o_lru, o_da], axis=-1)
        h = h + o @ w_out[l]
        gate = jax.nn.sigmoid(h @ ple_gate_w[l])
        h = h + gate * (p[l] @ ple_w[l])
    return rmsnorm(h, final_norm)


def setup_inputs(seed: int = 0) -> dict:
    key = jax.random.key(seed)
    ks = jax.random.split(key, 24)
    f32 = jnp.float32

    def nrm(k, shape, scale):
        return jax.random.normal(k, shape, dtype=f32) * scale

    a0 = jax.random.uniform(ks[15], (DEPTH, 2, LRU_WIDTH), dtype=f32, minval=0.9, maxval=0.999)
    s0 = a0 ** (1.0 / LRU_C)
    return {
        'x_prompt': nrm(ks[0], (BATCH, SEQ, D_MODEL), 1.0),
        'x_sample': nrm(ks[1], (DEC_BATCH, DEC_SEQ, D_MODEL), 1.0),
        'p_prompt': nrm(ks[2], (DEPTH, BATCH, SEQ, PLE_DIM), 1.0),
        'p_sample': nrm(ks[3], (DEPTH, DEC_BATCH, DEC_SEQ, PLE_DIM), 1.0),
        'norm_g': 1.0 + nrm(ks[4], (DEPTH, D_MODEL), 0.05),
        'w_in': nrm(ks[5], (DEPTH, D_MODEL, D_IN), D_MODEL ** -0.5),
        'w_out': nrm(ks[6], (DEPTH, D_MIX, D_MODEL), D_MIX ** -0.5),
        'hg_lb': nrm(ks[7], (DEPTH, 2, HG_HEADS * HG_DK), 0.5),
        'hg_norm': 1.0 + nrm(ks[8], (DEPTH, HG_DV), 0.05),
        'lru_conv_w': nrm(ks[9], (DEPTH, CONV_W, LRU_WIDTH), CONV_W ** -0.5),
        'lru_conv_b': nrm(ks[10], (DEPTH, LRU_WIDTH), 0.01),
        'lru_wa': nrm(ks[11], (DEPTH, 2, LRU_BLOCKS, LRU_BLOCK, LRU_BLOCK), LRU_BLOCK ** -0.5),
        'lru_ba': nrm(ks[12], (DEPTH, 2, LRU_WIDTH), 0.01),
        'lru_wx': nrm(ks[13], (DEPTH, 2, LRU_BLOCKS, LRU_BLOCK, LRU_BLOCK), LRU_BLOCK ** -0.5),
        'lru_bx': nrm(ks[14], (DEPTH, 2, LRU_WIDTH), 0.01),
        'lru_lam': jnp.log(s0) - jnp.log1p(-s0),
        'da_lq1': nrm(ks[16], (DEPTH, DA_HEAD_QK), 0.1),
        'da_lk1': nrm(ks[17], (DEPTH, DA_HEAD_QK), 0.1),
        'da_lq2': nrm(ks[18], (DEPTH, DA_HEAD_QK), 0.1),
        'da_lk2': nrm(ks[19], (DEPTH, DA_HEAD_QK), 0.1),
        'da_norm': 1.0 + nrm(ks[20], (DEPTH, DA_HEAD_V), 0.05),
        'ple_w': nrm(ks[21], (DEPTH, PLE_DIM, D_MODEL), PLE_DIM ** -0.5),
        'ple_gate_w': nrm(ks[22], (DEPTH, D_MODEL, D_MODEL), D_MODEL ** -0.5),
        'final_norm': 1.0 + nrm(ks[23], (D_MODEL,), 0.05),
    }


def reference(x_prompt, x_sample, p_prompt, p_sample, norm_g, w_in, w_out, hg_lb, hg_norm,
              lru_conv_w, lru_conv_b, lru_wa, lru_ba, lru_wx, lru_bx, lru_lam, da_lq1, da_lk1,
              da_lq2, da_lk2, da_norm, ple_w, ple_gate_w, final_norm):
    y_prompt = trunk(x_prompt, p_prompt, norm_g, w_in, w_out, hg_lb, hg_norm, lru_conv_w,
                     lru_conv_b, lru_wa, lru_ba, lru_wx, lru_bx, lru_lam, da_lq1, da_lk1,
                     da_lq2, da_lk2, da_norm, ple_w, ple_gate_w, final_norm)
    y_sample = trunk(x_sample, p_sample, norm_g, w_in, w_out, hg_lb, hg_norm, lru_conv_w,
                     lru_conv_b, lru_wa, lru_ba, lru_wx, lru_bx, lru_lam, da_lq1, da_lk1,
                     da_lq2, da_lk2, da_norm, ple_w, ple_gate_w, final_norm)
    return (y_prompt, y_sample)
```

```cpp
#include <hip/hip_runtime.h>
#include <hip/hip_cooperative_groups.h>
#include <cstdio>
namespace cg = cooperative_groups;

#ifndef PROBE_DUP
#define PROBE_DUP 0
#endif
#ifndef COOP
#define COOP 1
#endif

typedef unsigned short u16;
typedef __attribute__((ext_vector_type(8))) short bf16x8;
typedef __attribute__((ext_vector_type(4))) float f32x4;

constexpr int T_TOK = 98304;
constexpr int T_PROMPT = 65536;
constexpr int DM = 1024;
constexpr int DIN = 3328;
constexpr int C_HQ = 0, C_HFF = 256, C_HFB = 512, C_HI = 768, C_HG = 1024, C_LX = 1280, C_LG = 1792,
              C_DQ = 2304, C_DK = 2560, C_DV = 2816, C_DG = 3072;
constexpr int NCHUNK = T_TOK / 64;
constexpr int LDS_BYTES = 73728 + 16;
constexpr int NPHASE = 1 + 7 * 2 + 1;
constexpr float RMS_EPS = 1e-6f;

struct Params {
  const float* x_prompt; const float* x_sample; const float* p_prompt; const float* p_sample;
  const float* norm_g; const float* w_in; const float* w_out; const float* hg_lb; const float* hg_norm;
  const float* conv_w; const float* conv_b; const float* wa; const float* ba; const float* wx; const float* bx;
  const float* lru_lam; const float* lq1; const float* lk1; const float* lq2; const float* lk2;
  const float* da_norm; const float* ple_w; const float* gate_w; const float* final_norm;
  float* out;
  u16* Z; u16* ACT; u16* VT; u16* PB; float* CA; float* CB;
  u16* WIN; u16* WOUT; u16* WGATE; u16* WPLE; u16* WLRU; float* ROPE; float* SP8; unsigned* CTR; unsigned* BAR; unsigned* KMAX;
  int phase_lo; int phase_hi;
};

__device__ __forceinline__ int TIDX() { int t = threadIdx.x; asm volatile("" : "+v"(t)); return t; }
__device__ __forceinline__ int BIDX() { int b = blockIdx.x; asm volatile("" : "+s"(b)); return b; }
__device__ __forceinline__ float bf2f(unsigned h) { return __uint_as_float(h << 16); }
__device__ __forceinline__ unsigned f2bf(float f) {
  return (unsigned)__builtin_bit_cast(unsigned short, (__bf16)f);
}
typedef __bf16 bf16x2_t __attribute__((ext_vector_type(2)));
typedef float f32x2_t __attribute__((ext_vector_type(2)));
__device__ __forceinline__ unsigned pack2(float a, float b) {
  f32x2_t v = {a, b};
  bf16x2_t r = __builtin_convertvector(v, bf16x2_t);
  return __builtin_bit_cast(unsigned, r);
}
__device__ __forceinline__ unsigned pack2_hw(float a, float b) { return pack2(a, b); }
__device__ __forceinline__ float lo_f(unsigned w) { return __uint_as_float(w << 16); }
__device__ __forceinline__ float hi_f(unsigned w) { return __uint_as_float(w & 0xffff0000u); }
__device__ __forceinline__ void unpack8(const uint4& v, float* x) {
  x[0] = lo_f(v.x); x[1] = hi_f(v.x); x[2] = lo_f(v.y); x[3] = hi_f(v.y);
  x[4] = lo_f(v.z); x[5] = hi_f(v.z); x[6] = lo_f(v.w); x[7] = hi_f(v.w);
}
__device__ __forceinline__ uint4 pack8(const float* x) {
  uint4 v; v.x = pack2_hw(x[0], x[1]); v.y = pack2_hw(x[2], x[3]); v.z = pack2_hw(x[4], x[5]); v.w = pack2_hw(x[6], x[7]);
  return v;
}
__device__ __forceinline__ bf16x8 as_bf8(const uint4& v) { return __builtin_bit_cast(bf16x8, v); }
__device__ __forceinline__ float sigmoidf_(float x) { return __builtin_amdgcn_rcpf(1.0f + __expf(-x)); }
__device__ __forceinline__ float siluf_(float x) { return x * __builtin_amdgcn_rcpf(1.0f + __expf(-x)); }
__device__ __forceinline__ f32x4 mfma16(bf16x8 a, bf16x8 b, f32x4 c) {
  return __builtin_amdgcn_mfma_f32_16x16x32_bf16(a, b, c, 0, 0, 0);
}
__device__ __forceinline__ int tok_pos(int t) { return t < T_PROMPT ? (t & 4095) : ((t - T_PROMPT) & 2047); }
__device__ __forceinline__ int tok_len(int t) { return t < T_PROMPT ? 4096 : 2048; }
__device__ __forceinline__ void seq_info(int seq, int& base, int& len) {
  if (seq < 16) { base = seq << 12; len = 4096; } else { base = T_PROMPT + ((seq - 16) << 11); len = 2048; }
}
__device__ __forceinline__ const float* x_row(const Params& p, int t) {
  return t < T_PROMPT ? p.x_prompt + (size_t)t * DM : p.x_sample + (size_t)(t - T_PROMPT) * DM;
}
__device__ __forceinline__ const float* p_row(const Params& p, int l, int t) {
  return t < T_PROMPT ? p.p_prompt + ((size_t)l * T_PROMPT + t) * 256
                      : p.p_sample + ((size_t)l * (T_TOK - T_PROMPT) + (t - T_PROMPT)) * 256;
}

struct TileIter { int v, end, step; };
__device__ __forceinline__ TileIter tile_iter(int NT) {
  int G = gridDim.x;
  TileIter it;
  if (G & 7) { it.v = BIDX(); it.end = NT; it.step = G; return it; }
  int per = (NT + 7) >> 3; int x = BIDX() & 7;
  it.v = x * per + (BIDX() >> 3); it.end = min((x + 1) * per, NT); it.step = G >> 3;
  return it;
}

__device__ void transpose_tile(const float* __restrict__ src, u16* __restrict__ dst, int K, int N, int tile, float* sm) {
  const int tid = TIDX();
  const int ntn = N >> 6;
  const int k0 = (tile / ntn) << 6, n0 = (tile % ntn) << 6;
  __syncthreads();
#pragma unroll
  for (int i = 0; i < 16; ++i) {
    int k = (tid >> 6) + 4 * i, n = tid & 63;
    sm[k * 65 + n] = src[(size_t)(k0 + k) * N + n0 + n];
  }
  __syncthreads();
#pragma unroll
  for (int i = 0; i < 16; ++i) {
    int n = (tid >> 6) + 4 * i, k = tid & 63;
    dst[(size_t)(n0 + n) * K + k0 + k] = (u16)f2bf(sm[k * 65 + n]);
  }
}

__device__ void phase_prep(const Params& p, unsigned char* smem) {
  float* sm = (float*)smem;
  for (int it = BIDX(); it < 2 * 1408; it += gridDim.x) {
    int l = it / 1408, r = it % 1408;
    if (r < 832) transpose_tile(p.w_in + (size_t)l * DM * DIN, p.WIN + (size_t)l * DIN * DM, DM, DIN, r, sm);
    else if (r < 1088) transpose_tile(p.w_out + (size_t)l * DM * DM, p.WOUT + (size_t)l * DM * DM, DM, DM, r - 832, sm);
    else if (r < 1344) transpose_tile(p.gate_w + (size_t)l * DM * DM, p.WGATE + (size_t)l * DM * DM, DM, DM, r - 1088, sm);
    else transpose_tile(p.ple_w + (size_t)l * 256 * DM, p.WPLE + (size_t)l * DM * 256, 256, DM, r - 1344, sm);
  }
  const int gt = BIDX() * 256 + TIDX(), gn = gridDim.x * 256;
  if (gt < 64) p.CTR[gt] = 0u;
  if (gt < 512) p.KMAX[gt] = 0u;
  for (int i = gt; i < 4096 * 4; i += gn) {
    int pos = i >> 2, k = i & 3;
    float inv = (k == 0) ? 1.0f : (k == 1) ? 0.037606030930863934f : (k == 2) ? 0.0014142135623730950f : 5.3183006600460594e-05f;
    float ang = (float)pos * inv;
    float nrev = rintf(ang * 0.15915494309189535f);
    float r = fmaf(-nrev, 6.28318548202514648f, ang);
    r = fmaf(-nrev, -1.74845553e-07f, r);
    p.ROPE[2 * i] = __cosf(r);
    p.ROPE[2 * i + 1] = __sinf(r);
  }
  for (int i = gt; i < 2 * 2 * 512; i += gn) {
    float nl = -p.lru_lam[i];
    p.SP8[i] = -8.0f * (fmaxf(nl, 0.f) + log1pf(__expf(-fabsf(nl))));
  }
  for (int i = gt; i < 2 * 2 * 2 * 8 * 4096; i += gn) {
    int c = i & 63, e = (i >> 6) & 63, blk = (i >> 12) & 7, mat = (i >> 15) & 1, d = (i >> 16) & 1, l = (i >> 17) & 1;
    const float* src = mat ? p.wx : p.wa;
    p.WLRU[i] = (u16)f2bf(src[((((size_t)(l * 2 + d) * 8 + blk) * 64 + c) * 64) + e]);
  }
}

__device__ void phase_norm(const Params& p, int l, bool fin) {
  const int lane = TIDX() & 63;
  const int gw = BIDX() * 4 + (TIDX() >> 6), nw = gridDim.x * 4;
  const float* g = fin ? p.final_norm : p.norm_g + l * DM;
  float4 gg[4];
#pragma unroll
  for (int i = 0; i < 4; ++i) gg[i] = ((const float4*)g)[lane + 64 * i];
  for (int row = gw; row < T_TOK; row += 2 * nw) {
    const int row2 = row + nw;
    const bool has2 = row2 < T_TOK;
    const float* src = (l == 0 && !fin) ? x_row(p, row) : p.out + (size_t)row * DM;
    const float* src2 = has2 ? ((l == 0 && !fin) ? x_row(p, row2) : p.out + (size_t)row2 * DM) : src;
    float4 v[4], u[4];
#pragma unroll
    for (int i = 0; i < 4; ++i) {
      typedef float f4v __attribute__((ext_vector_type(4)));
      const f4v a = __builtin_nontemporal_load((const f4v*)src + lane + 64 * i);
      const f4v b = __builtin_nontemporal_load((const f4v*)src2 + lane + 64 * i);
      v[i] = make_float4(a[0], a[1], a[2], a[3]); u[i] = make_float4(b[0], b[1], b[2], b[3]);
    }
    float ss = 0.f, ss2 = 0.f;
#pragma unroll
    for (int i = 0; i < 4; ++i) {
      ss += v[i].x * v[i].x + v[i].y * v[i].y + v[i].z * v[i].z + v[i].w * v[i].w;
      ss2 += u[i].x * u[i].x + u[i].y * u[i].y + u[i].z * u[i].z + u[i].w * u[i].w;
    }
#pragma unroll
    for (int o = 32; o >= 1; o >>= 1) { ss += __shfl_xor(ss, o); ss2 += __shfl_xor(ss2, o); }
    const float rs = rsqrtf(ss * (1.0f / 1024.0f) + RMS_EPS), rs2 = rsqrtf(ss2 * (1.0f / 1024.0f) + RMS_EPS);
#pragma unroll
    for (int i = 0; i < 4; ++i) {
      float4 y; y.x = v[i].x * rs * gg[i].x; y.y = v[i].y * rs * gg[i].y; y.z = v[i].z * rs * gg[i].z; y.w = v[i].w * rs * gg[i].w;
      float4 y2; y2.x = u[i].x * rs2 * gg[i].x; y2.y = u[i].y * rs2 * gg[i].y; y2.z = u[i].z * rs2 * gg[i].z; y2.w = u[i].w * rs2 * gg[i].w;
      if (fin) {
        typedef float f4v __attribute__((ext_vector_type(4)));
        const f4v ya = {y.x, y.y, y.z, y.w}, yb = {y2.x, y2.y, y2.z, y2.w};
        __builtin_nontemporal_store(ya, (f4v*)(p.out + (size_t)row * DM) + lane + 64 * i);
        if (has2) __builtin_nontemporal_store(yb, (f4v*)(p.out + (size_t)row2 * DM) + lane + 64 * i);
      } else {
        uint2 o2; o2.x = pack2_hw(y.x, y.y); o2.y = pack2_hw(y.z, y.w); ((uint2*)(p.ACT + (size_t)row * DM))[lane + 64 * i] = o2;
        if (has2) { uint2 o3; o3.x = pack2_hw(y2.x, y2.y); o3.y = pack2_hw(y2.z, y2.w); ((uint2*)(p.ACT + (size_t)row2 * DM))[lane + 64 * i] = o3; }
      }
    }
  }
  if (!fin) {
    const int total = T_TOK * 64;
    for (int i = BIDX() * 256 + TIDX(); i < total; i += gridDim.x * 256) {
      int t = i >> 6, c4 = i & 63;
      typedef float f4v __attribute__((ext_vector_type(4)));
      const f4v pv4 = __builtin_nontemporal_load((const f4v*)p_row(p, l, t) + c4);
      float4 v = make_float4(pv4[0], pv4[1], pv4[2], pv4[3]);
      uint2 o2; o2.x = pack2_hw(v.x, v.y); o2.y = pack2_hw(v.z, v.w);
      ((uint2*)(p.PB + (size_t)t * 256))[c4] = o2;
    }
  }
}

template <int NT>
__device__ __forceinline__ void gemm_mainloop(const u16* __restrict__ A, int lda, const u16* __restrict__ B, int ldb,
                                              int K, f32x4 (&acc)[4][NT], u16* sm) {
  static_assert(NT == 4, "only NT=4");
  const int tid = TIDX(), lane = tid & 63, w = tid >> 6, wm = w >> 1, wn = w & 1, l15 = lane & 15, g = lane >> 4;
  u16* sA = sm; u16* sB = sm + 2 * 128 * 72;
  const int lr = tid >> 3, lc = (tid & 7) * 8;
  const u16* ga = A + (size_t)lr * lda + lc;
  const u16* gb = B + (size_t)lr * ldb + lc;
  const size_t sa32 = (size_t)32 * lda, sb32 = (size_t)32 * ldb;
  uint4 ra0, ra1, ra2, ra3, rb0, rb1, rb2, rb3;
  ra0 = *(const uint4*)(ga); ra1 = *(const uint4*)(ga + sa32); ra2 = *(const uint4*)(ga + 2 * sa32); ra3 = *(const uint4*)(ga + 3 * sa32);
  rb0 = *(const uint4*)(gb); rb1 = *(const uint4*)(gb + sb32); rb2 = *(const uint4*)(gb + 2 * sb32); rb3 = *(const uint4*)(gb + 3 * sb32);
  {
    u16* wA = sA + lr * 72 + lc; u16* wB = sB + lr * 72 + lc;
    *(uint4*)(wA) = ra0; *(uint4*)(wA + 32 * 72) = ra1; *(uint4*)(wA + 64 * 72) = ra2; *(uint4*)(wA + 96 * 72) = ra3;
    *(uint4*)(wB) = rb0; *(uint4*)(wB + 32 * 72) = rb1; *(uint4*)(wB + 64 * 72) = rb2; *(uint4*)(wB + 96 * 72) = rb3;
  }
  __syncthreads();
  const int nk = K >> 6;
  for (int kt = 0; kt < nk; ++kt) {
    const int cur = kt & 1;
    const bool more = (kt + 1 < nk);
    if (more) {
      const u16* pa = ga + (kt + 1) * 64; const u16* pb = gb + (kt + 1) * 64;
      ra0 = *(const uint4*)(pa); ra1 = *(const uint4*)(pa + sa32); ra2 = *(const uint4*)(pa + 2 * sa32); ra3 = *(const uint4*)(pa + 3 * sa32);
      rb0 = *(const uint4*)(pb); rb1 = *(const uint4*)(pb + sb32); rb2 = *(const uint4*)(pb + 2 * sb32); rb3 = *(const uint4*)(pb + 3 * sb32);
    }
    __builtin_amdgcn_sched_barrier(0);
    const u16* cA = sA + cur * 128 * 72 + (wm * 64 + l15) * 72 + g * 8;
    const u16* cB = sB + cur * 128 * 72 + (wn * 64 + l15) * 72 + g * 8;
#pragma unroll
    for (int ks = 0; ks < 2; ++ks) {
      bf16x8 af[4], bfr[4];
#pragma unroll
      for (int i = 0; i < 4; ++i) {
        af[i] = *(const bf16x8*)(cA + i * 16 * 72 + ks * 32);
        bfr[i] = *(const bf16x8*)(cB + i * 16 * 72 + ks * 32);
      }
#pragma unroll
      for (int mt = 0; mt < 4; ++mt)
#pragma unroll
        for (int nt = 0; nt < 4; ++nt) acc[mt][nt] = mfma16(bfr[nt], af[mt], acc[mt][nt]);
    }
    __builtin_amdgcn_sched_barrier(0);
    if (more) {
      u16* wA = sA + (cur ^ 1) * 128 * 72 + lr * 72 + lc; u16* wB = sB + (cur ^ 1) * 128 * 72 + lr * 72 + lc;
      *(uint4*)(wA) = ra0; *(uint4*)(wA + 32 * 72) = ra1; *(uint4*)(wA + 64 * 72) = ra2; *(uint4*)(wA + 96 * 72) = ra3;
      *(uint4*)(wB) = rb0; *(uint4*)(wB + 32 * 72) = rb1; *(uint4*)(wB + 64 * 72) = rb2; *(uint4*)(wB + 96 * 72) = rb3;
    }
    __syncthreads();
  }
}

__device__ __forceinline__ void gemm_mainloop2(const u16* __restrict__ A, int lda, const u16* __restrict__ B, int ldb,
                                               int K, f32x4 (&acc)[4][8], u16* sm) {
  const int tid = TIDX(), lane = tid & 63, w = tid >> 6, wm = w >> 1, wn = w & 1, l15 = lane & 15, g = lane >> 4;
  constexpr int SZ = 384 * 40;
  const int lr = tid >> 2, lc = (tid & 3) * 8;
  const u16* ga = A + (size_t)lr * lda + lc;
  const u16* gb = B + (size_t)lr * ldb + lc;
  const size_t sa64 = (size_t)64 * lda, sb64 = (size_t)64 * ldb;
  uint4 ra0, ra1, rb0, rb1, rb2, rb3;
  ra0 = *(const uint4*)(ga); ra1 = *(const uint4*)(ga + sa64);
  rb0 = *(const uint4*)(gb); rb1 = *(const uint4*)(gb + sb64); rb2 = *(const uint4*)(gb + 2 * sb64); rb3 = *(const uint4*)(gb + 3 * sb64);
  {
    u16* wA = sm + lr * 40 + lc; u16* wB = sm + 128 * 40 + lr * 40 + lc;
    *(uint4*)(wA) = ra0; *(uint4*)(wA + 64 * 40) = ra1;
    *(uint4*)(wB) = rb0; *(uint4*)(wB + 64 * 40) = rb1; *(uint4*)(wB + 128 * 40) = rb2; *(uint4*)(wB + 192 * 40) = rb3;
  }
  __syncthreads();
  const int nk = K >> 5;
  for (int kt = 0; kt < nk; ++kt) {
    const int cur = kt & 1;
    const bool more = (kt + 1 < nk);
    if (more) {
      const u16* pa = ga + (kt + 1) * 32; const u16* pb = gb + (kt + 1) * 32;
      ra0 = *(const uint4*)(pa); ra1 = *(const uint4*)(pa + sa64);
      rb0 = *(const uint4*)(pb); rb1 = *(const uint4*)(pb + sb64); rb2 = *(const uint4*)(pb + 2 * sb64); rb3 = *(const uint4*)(pb + 3 * sb64);
    }
    __builtin_amdgcn_sched_barrier(0);
    const u16* cA = sm + cur * SZ + (wm * 64 + l15) * 40 + g * 8;
    const u16* cB = sm + cur * SZ + 128 * 40 + (wn * 128 + l15) * 40 + g * 8;
    bf16x8 af[4];
#pragma unroll
    for (int i = 0; i < 4; ++i) af[i] = *(const bf16x8*)(cA + i * 16 * 40);
#pragma unroll
    for (int nh = 0; nh < 2; ++nh) {
      bf16x8 bfr[4];
#pragma unroll
      for (int i = 0; i < 4; ++i) bfr[i] = *(const bf16x8*)(cB + (nh * 4 + i) * 16 * 40);
#pragma unroll
      for (int mt = 0; mt < 4; ++mt)
#pragma unroll
        for (int nt = 0; nt < 4; ++nt) acc[mt][nh * 4 + nt] = mfma16(bfr[nt], af[mt], acc[mt][nh * 4 + nt]);
    }
    __builtin_amdgcn_sched_barrier(0);
    if (more) {
      u16* wA = sm + (cur ^ 1) * SZ + lr * 40 + lc; u16* wB = sm + (cur ^ 1) * SZ + 128 * 40 + lr * 40 + lc;
      *(uint4*)(wA) = ra0; *(uint4*)(wA + 64 * 40) = ra1;
      *(uint4*)(wB) = rb0; *(uint4*)(wB + 64 * 40) = rb1; *(uint4*)(wB + 128 * 40) = rb2; *(uint4*)(wB + 192 * 40) = rb3;
    }
    __syncthreads();
  }
}

__device__ __forceinline__ void gemm_mainloop3(const u16* __restrict__ A, int lda, const u16* __restrict__ B, int ldb,
                                               int K, f32x4 (&acc)[4][8], unsigned char* smb) {
  const int tid = TIDX(), lane = tid & 63, w = tid >> 6, wm = w >> 1, wn = w & 1, l15 = lane & 15, g = lane >> 4;
  constexpr int STG = 24576;
  const int rowt = tid >> 2;
  const int cl = ((tid & 3) ^ (((tid >> 5) & 1) << 1)) * 8;
  const u16* ga = A + (size_t)rowt * lda + cl;
  const u16* gb = B + (size_t)rowt * ldb + cl;
  const size_t sa64 = (size_t)64 * lda, sb64 = (size_t)64 * ldb;
  unsigned char* wbase = smb + w * 1024;
#define GLDS16(gp, lp) __builtin_amdgcn_global_load_lds((const unsigned*)(gp), (unsigned*)(lp), 16, 0, 0)
#define ISSUE_TILE(kt_, stg_) do { \
    unsigned char* sb_ = wbase + (stg_) * STG; const u16* pa_ = ga + (kt_) * 32; const u16* pb_ = gb + (kt_) * 32; \
    GLDS16(pa_, sb_); GLDS16(pa_ + sa64, sb_ + 4096); \
    GLDS16(pb_, sb_ + 8192); GLDS16(pb_ + sb64, sb_ + 8192 + 4096); \
    GLDS16(pb_ + 2 * sb64, sb_ + 8192 + 8192); GLDS16(pb_ + 3 * sb64, sb_ + 8192 + 12288); } while (0)
  ISSUE_TILE(0, 0);
  asm volatile("s_waitcnt vmcnt(0)" ::: "memory");
  __syncthreads();
  const int csw = (g ^ (((l15 >> 3) & 1) << 1)) * 16;
  const int nk = K >> 5;
  for (int kt = 0; kt < nk; ++kt) {
    const int cur = kt & 1;
    if (kt + 1 < nk) ISSUE_TILE(kt + 1, cur ^ 1);
    __builtin_amdgcn_sched_barrier(0);
    const unsigned char* cA = smb + cur * STG + (wm * 64 + l15) * 64 + csw;
    const unsigned char* cB = smb + cur * STG + 8192 + (wn * 128 + l15) * 64 + csw;
    bf16x8 af[4];
#pragma unroll
    for (int i = 0; i < 4; ++i) af[i] = *(const bf16x8*)(cA + i * 16 * 64);
#pragma unroll
    for (int nh = 0; nh < 2; ++nh) {
      bf16x8 bfr[4];
#pragma unroll
      for (int i = 0; i < 4; ++i) bfr[i] = *(const bf16x8*)(cB + (nh * 4 + i) * 16 * 64);
#pragma unroll
      for (int nt = 0; nt < 4; ++nt)
#pragma unroll
        for (int mt = 0; mt < 4; ++mt) acc[mt][nh * 4 + nt] = mfma16(bfr[nt], af[mt], acc[mt][nh * 4 + nt]);
    }
    __builtin_amdgcn_sched_group_barrier(0x100, 6, 0);
#pragma unroll
    for (int i = 0; i < 6; ++i) {
      __builtin_amdgcn_sched_group_barrier(0x008, 4, 0);
      __builtin_amdgcn_sched_group_barrier(0x100, 1, 0);
    }
    __builtin_amdgcn_sched_group_barrier(0x008, 8, 0);
    __builtin_amdgcn_sched_barrier(0);
    asm volatile("s_waitcnt vmcnt(0)" ::: "memory");
    __syncthreads();
  }
#undef ISSUE_TILE
#undef GLDS16
}

__device__ __forceinline__ void gemm_mainloop4(const u16* __restrict__ A, int lda, const u16* __restrict__ B, int ldb,
                                               int K, f32x4 (&acc)[4][4], unsigned char* smb) {
  const int tid = TIDX(), lane = tid & 63, w = tid >> 6, wm = w >> 1, wn = w & 1, l15 = lane & 15, g = lane >> 4;
  constexpr int STG = 32768;
  const int rowt = tid >> 2;
  const int cl = ((tid & 3) ^ (((tid >> 5) & 1) << 1)) * 8;
  const u16* ga = A + (size_t)rowt * lda + cl;
  const u16* gb = B + (size_t)rowt * ldb + cl;
  const size_t sa64 = (size_t)64 * lda, sb64 = (size_t)64 * ldb;
  unsigned char* wbase = smb + w * 1024;
#define GLDS16(gp, lp) __builtin_amdgcn_global_load_lds((const unsigned*)(gp), (unsigned*)(lp), 16, 0, 0)
#define ISSUE_TILE4(kt_, stg_) do { \
    unsigned char* sb_ = wbase + (stg_) * STG; const u16* pa_ = ga + (kt_) * 64; const u16* pb_ = gb + (kt_) * 64; \
    GLDS16(pa_, sb_); GLDS16(pa_ + sa64, sb_ + 4096); \
    GLDS16(pa_ + 32, sb_ + 8192); GLDS16(pa_ + sa64 + 32, sb_ + 8192 + 4096); \
    GLDS16(pb_, sb_ + 16384); GLDS16(pb_ + sb64, sb_ + 16384 + 4096); \
    GLDS16(pb_ + 32, sb_ + 24576); GLDS16(pb_ + sb64 + 32, sb_ + 24576 + 4096); } while (0)
  __syncthreads();
  ISSUE_TILE4(0, 0);
  asm volatile("s_waitcnt vmcnt(0)" ::: "memory");
  __syncthreads();
  const int csw = (g ^ (((l15 >> 3) & 1) << 1)) * 16;
  const int nk = K >> 6;
  for (int kt = 0; kt < nk; ++kt) {
    const int cur = kt & 1;
    if (kt + 1 < nk) ISSUE_TILE4(kt + 1, cur ^ 1);
#pragma unroll
    for (int ks = 0; ks < 2; ++ks) {
      const unsigned char* cA = smb + cur * STG + ks * 8192 + (wm * 64 + l15) * 64 + csw;
      const unsigned char* cB = smb + cur * STG + 16384 + ks * 8192 + (wn * 64 + l15) * 64 + csw;
      bf16x8 af[4], bfr[4];
#pragma unroll
      for (int i = 0; i < 4; ++i) { af[i] = *(const bf16x8*)(cA + i * 1024); bfr[i] = *(const bf16x8*)(cB + i * 1024); }
#pragma unroll
      for (int nt = 0; nt < 4; ++nt)
#pragma unroll
        for (int mt = 0; mt < 4; ++mt) acc[mt][nt] = mfma16(bfr[nt], af[mt], acc[mt][nt]);
    }
    asm volatile("s_waitcnt vmcnt(0)" ::: "memory");
    __syncthreads();
  }
#undef ISSUE_TILE4
#undef GLDS16
}

__device__ __forceinline__ void acc2_to_lds(const f32x4 (&acc)[4][8], float* ct, int hf) {
  const int tid = TIDX(), lane = tid & 63, w = tid >> 6, wm = w >> 1, wn = w & 1, l15 = lane & 15, g = lane >> 4;
#pragma unroll
  for (int mt = 0; mt < 4; ++mt)
#pragma unroll
    for (int nt = 0; nt < 4; ++nt)
      *(f32x4*)(ct + (wm * 64 + mt * 16 + l15) * 132 + wn * 64 + nt * 16 + 4 * g) = acc[mt][hf * 4 + nt];
  __syncthreads();
}

__device__ __forceinline__ void tile_mn(int v, int ntn, int bn, int& m0, int& n0) {
  int grp = v / (8 * ntn), r = v % (8 * ntn);
  m0 = (grp * 8 + (r & 7)) * 128; n0 = (r >> 3) * bn;
}

#define ZERO_ACC(acc) _Pragma("unroll") for (int _a = 0; _a < 4; ++_a) _Pragma("unroll") for (int _b = 0; _b < 4; ++_b) acc[_a][_b] = f32x4{0.f, 0.f, 0.f, 0.f};

__device__ __forceinline__ void acc_to_lds(const f32x4 (&acc)[4][4], float* ct) {
  const int tid = TIDX(), lane = tid & 63, w = tid >> 6, wm = w >> 1, wn = w & 1, l15 = lane & 15, g = lane >> 4;
#pragma unroll
  for (int mt = 0; mt < 4; ++mt)
#pragma unroll
    for (int nt = 0; nt < 4; ++nt)
      *(f32x4*)(ct + (wm * 64 + mt * 16 + l15) * 132 + wn * 64 + nt * 16 + 4 * g) = acc[mt][nt];
  __syncthreads();
}

__device__ void phase_gemm_in(const Params& p, int l, unsigned char* smem) {
  const int ntn = DIN / 256;
  float* ct = (float*)smem;
  TileIter it = tile_iter((T_TOK / 128) * ntn);
  for (int v = it.v; v < it.end; v += it.step) {
    int m0, n0; tile_mn(v, ntn, 256, m0, n0);
    f32x4 acc[4][8];
#pragma unroll
    for (int a = 0; a < 4; ++a)
#pragma unroll
      for (int b = 0; b < 8; ++b) acc[a][b] = f32x4{0.f, 0.f, 0.f, 0.f};
    gemm_mainloop3(p.ACT + (size_t)m0 * DM, DM, p.WIN + (size_t)l * DIN * DM + (size_t)n0 * DM, DM, DM, acc, smem);
    const int tid = TIDX();
    const bool dv = (n0 >= C_DV && n0 < C_DG);
#pragma unroll
    for (int hf = 0; hf < 2; ++hf) {
      acc2_to_lds(acc, ct, hf);
      if (!dv) {
#pragma unroll
        for (int i = 0; i < 16; ++i) {
          int idx = tid + 256 * i, r = idx >> 5, c4 = idx & 31;
          float4 x = *(const float4*)(ct + r * 132 + 4 * c4);
          uint2 o2; o2.x = pack2(x.x, x.y); o2.y = pack2(x.z, x.w);
          *(uint2*)(p.Z + (size_t)(m0 + r) * DIN + n0 + (c4 >> 4) * 128 + hf * 64 + (c4 & 15) * 4) = o2;
        }
      } else {
#pragma unroll
        for (int i = 0; i < 16; ++i) {
          int idx = tid + 256 * i, n = idx >> 5, m4 = idx & 31;
          uint2 o2;
          o2.x = pack2(ct[(4 * m4 + 0) * 132 + n], ct[(4 * m4 + 1) * 132 + n]);
          o2.y = pack2(ct[(4 * m4 + 2) * 132 + n], ct[(4 * m4 + 3) * 132 + n]);
          const int ng = n0 + (n >> 6) * 128 + hf * 64 + (n & 63);
          *(uint2*)(p.VT + (size_t)(ng - C_DV) * T_TOK + m0 + 4 * m4) = o2;
        }
      }
      __syncthreads();
    }
  }
}

__device__ void phase_gemm_out(const Params& p, int l, unsigned char* smem, bool dry = false) {
  const int ntn = DM / 256;
  u16* H1B = p.Z;
  float* ct = (float*)smem;
  TileIter it = tile_iter((T_TOK / 128) * ntn);
  for (int v = it.v; v < it.end; v += it.step) {
    int m0, n0; tile_mn(v, ntn, 256, m0, n0);
    f32x4 acc[4][8];
#pragma unroll
    for (int a = 0; a < 4; ++a)
#pragma unroll
      for (int b = 0; b < 8; ++b) acc[a][b] = f32x4{0.f, 0.f, 0.f, 0.f};
    gemm_mainloop3(p.ACT + (size_t)m0 * DM, DM, p.WOUT + (size_t)l * DM * DM + (size_t)n0 * DM, DM, DM, acc, smem);
    const int tid = TIDX();
#pragma unroll
    for (int hf = 0; hf < 2; ++hf) {
      acc2_to_lds(acc, ct, hf);
#pragma unroll
      for (int i = 0; i < 16; ++i) {
        int idx = tid + 256 * i, r = idx >> 5, c4 = idx & 31;
        const int m = m0 + r, n = n0 + (c4 >> 4) * 128 + hf * 64 + (c4 & 15) * 4;
        float4 x = *(const float4*)(ct + r * 132 + 4 * c4);
        const float* hp = (l == 0) ? x_row(p, m) + n : p.out + (size_t)m * DM + n;
        typedef float f4v __attribute__((ext_vector_type(4)));
        const f4v hnt = __builtin_nontemporal_load((const f4v*)hp);
        float4 hv = make_float4(hnt[0], hnt[1], hnt[2], hnt[3]);
        float4 rr; rr.x = hv.x + x.x; rr.y = hv.y + x.y; rr.z = hv.z + x.z; rr.w = hv.w + x.w;
        if (!dry) {
          *(float4*)(p.out + (size_t)m * DM + n) = rr;
          uint2 o2; o2.x = pack2(rr.x, rr.y); o2.y = pack2(rr.z, rr.w);
          *(uint2*)(H1B + (size_t)m * DM + n) = o2;
        }
      }
      __syncthreads();
    }
  }
}

__device__ void phase_gemm_ple(const Params& p, int l, unsigned char* smem, bool dry = false) {
  const int ntn = DM / 128;
  const u16* H1B = p.Z;
  float* ct = (float*)smem;
  TileIter it = tile_iter((T_TOK / 128) * ntn);
  for (int v = it.v; v < it.end; v += it.step) {
    int m0, n0; tile_mn(v, ntn, 128, m0, n0);
    f32x4 acc[4][4]; ZERO_ACC(acc);
    gemm_mainloop4(H1B + (size_t)m0 * DM, DM, p.WGATE + (size_t)l * DM * DM + (size_t)n0 * DM, DM, DM, acc, smem);
    unsigned gpk[4][4][2];
#pragma unroll
    for (int mt = 0; mt < 4; ++mt)
#pragma unroll
      for (int nt = 0; nt < 4; ++nt) {
        gpk[mt][nt][0] = pack2_hw(sigmoidf_(acc[mt][nt][0]), sigmoidf_(acc[mt][nt][1]));
        gpk[mt][nt][1] = pack2_hw(sigmoidf_(acc[mt][nt][2]), sigmoidf_(acc[mt][nt][3]));
      }
    ZERO_ACC(acc);
    gemm_mainloop4(p.PB + (size_t)m0 * 256, 256, p.WPLE + (size_t)l * DM * 256 + (size_t)n0 * 256, 256, 256, acc, smem);
#pragma unroll
    for (int mt = 0; mt < 4; ++mt)
#pragma unroll
      for (int nt = 0; nt < 4; ++nt) {
        acc[mt][nt][0] *= lo_f(gpk[mt][nt][0]); acc[mt][nt][1] *= hi_f(gpk[mt][nt][0]);
        acc[mt][nt][2] *= lo_f(gpk[mt][nt][1]); acc[mt][nt][3] *= hi_f(gpk[mt][nt][1]);
      }
    acc_to_lds(acc, ct);
    const int tid = TIDX();
#pragma unroll
    for (int i = 0; i < 16; ++i) {
      int idx = tid + 256 * i, r = idx >> 5, c4 = idx & 31;
      float4 x = *(const float4*)(ct + r * 132 + 4 * c4);
      float* hp = p.out + (size_t)(m0 + r) * DM + n0 + 4 * c4;
      typedef float f4v __attribute__((ext_vector_type(4)));
      const f4v hnt = __builtin_nontemporal_load((const f4v*)hp);
      float4 hv = make_float4(hnt[0], hnt[1], hnt[2], hnt[3]);
      hv.x += x.x; hv.y += x.y; hv.z += x.z; hv.w += x.w;
      if (!dry) *(float4*)hp = hv;
    }
    __syncthreads();
  }
}

__device__ void phase_krope(const Params& p, int l) {
  for (int i = BIDX() * 256 + TIDX(); i < T_TOK * 8; i += gridDim.x * 256) {
    int t = i >> 3, hh = i & 7;
    u16* ptr = p.Z + (size_t)t * DIN + C_DK + hh * 32;
    uint4 raw = *(const uint4*)ptr;
    uint4 r1 = *(const uint4*)(ptr + 8), r2 = *(const uint4*)(ptr + 16), r3 = *(const uint4*)(ptr + 24);
    float x[8], y[8]; unpack8(raw, x);
    const float* rt = p.ROPE + (size_t)tok_pos(t) * 8;
#pragma unroll
    for (int k = 0; k < 4; ++k) {
      float c = rt[2 * k], s = rt[2 * k + 1];
      y[k] = x[k] * c - x[k + 4] * s;
      y[k + 4] = x[k + 4] * c + x[k] * s;
    }
    *(uint4*)ptr = pack8(y);
    float k2 = 0.f;
#pragma unroll
    for (int k = 0; k < 8; ++k) k2 += x[k] * x[k];
    float z[8];
    unpack8(r1, z);
#pragma unroll
    for (int k = 0; k < 8; ++k) k2 += z[k] * z[k];
    unpack8(r2, z);
#pragma unroll
    for (int k = 0; k < 8; ++k) k2 += z[k] * z[k];
    unpack8(r3, z);
#pragma unroll
    for (int k = 0; k < 8; ++k) k2 += z[k] * z[k];
    k2 = fmaxf(k2, __shfl_xor(k2, 8));
    k2 = fmaxf(k2, __shfl_xor(k2, 16));
    k2 = fmaxf(k2, __shfl_xor(k2, 32));
    if ((TIDX() & 63) < 8) {
      const int seq = t < T_PROMPT ? (t >> 12) : 16 + ((t - T_PROMPT) >> 11);
      atomicMax(p.KMAX + (l * 32 + seq) * 8 + hh, __float_as_uint(k2));
    }
  }
}

template <bool FINAL>
__device__ void phase_lru(const Params& p, int l, unsigned char* smem) {
  u16* xs = (u16*)smem;
  float* u32 = (float*)(smem + 8704);
  u16* ub = (u16*)(smem + 25088);
  float* sa = (float*)(smem + 34304);
  float* sb = (float*)(smem + 50688);
  float* part = (float*)(smem + 67072);
  const int tid = TIDX(), lane = tid & 63, w = tid >> 6, l15 = lane & 15, g = lane >> 4;
  const int e_ = tid & 63, qd = tid >> 6;
  const int NIT = NCHUNK * 8;
  const int step = gridDim.x;
  int it = BIDX();
  uint4 x0 = make_uint4(0, 0, 0, 0), x1 = x0, x2 = x0;
  auto load_x = [&](int item, uint4& a0, uint4& a1, uint4& a2) {
    const int ci = item >> 3, nb = item & 7;
    const int tb = ci * 64, pos0 = tok_pos(tb), S = tok_len(tb);
    const u16* zb = p.Z + (long)(tb - 2) * DIN + C_LX + nb * 64;
    { int idx = tid, r = idx >> 3, ch = idx & 7, pp = pos0 - 2 + r;
      a0 = (pp >= 0 && pp < S) ? *(const uint4*)(zb + (long)r * DIN + ch * 8) : make_uint4(0, 0, 0, 0); }
    { int idx = tid + 256, r = idx >> 3, ch = idx & 7, pp = pos0 - 2 + r;
      a1 = (pp >= 0 && pp < S) ? *(const uint4*)(zb + (long)r * DIN + ch * 8) : make_uint4(0, 0, 0, 0); }
    { int idx = tid + 512, r = idx >> 3, ch = idx & 7, pp = pos0 - 2 + r;
      a2 = (idx < 67 * 8 && pp >= 0 && pp < S) ? *(const uint4*)(zb + (long)r * DIN + ch * 8) : make_uint4(0, 0, 0, 0); }
  };
  if (it < NIT) load_x(it, x0, x1, x2);
  for (; it < NIT; it += step) {
    const int ci = it >> 3, nb = it & 7;
    const int tb = ci * 64;
    __syncthreads();
    *(uint4*)(xs + (tid >> 3) * 64 + (tid & 7) * 8) = x0;
    *(uint4*)(xs + ((tid + 256) >> 3) * 64 + (tid & 7) * 8) = x1;
    if (tid + 512 < 67 * 8) *(uint4*)(xs + ((tid + 512) >> 3) * 64 + (tid & 7) * 8) = x2;
    uint4 gz0 = make_uint4(0, 0, 0, 0), gz1 = gz0;
    float cin0 = 0.f, cin1 = 0.f;
    if (FINAL) {
      const u16* gb = p.Z + (size_t)tb * DIN + C_LG + nb * 64 + (tid & 7) * 8;
      typedef unsigned u4v __attribute__((ext_vector_type(4)));
      const u4v g0_ = __builtin_nontemporal_load((const u4v*)(gb + (size_t)(tid >> 3) * DIN));
      const u4v g1_ = __builtin_nontemporal_load((const u4v*)(gb + (size_t)((tid >> 3) + 32) * DIN));
      gz0 = make_uint4(g0_[0], g0_[1], g0_[2], g0_[3]);
      gz1 = make_uint4(g1_[0], g1_[1], g1_[2], g1_[3]);
      cin0 = p.CB[((size_t)ci * 2 + 0) * 512 + nb * 64 + e_];
      cin1 = p.CB[((size_t)ci * 2 + 1) * 512 + nb * 64 + e_];
    }
    __syncthreads();
    if (it + step < NIT) load_x(it + step, x0, x1, x2);
    {
      const int ch = nb * 64 + e_;
      const float cw0 = p.conv_w[(l * 4 + 0) * 512 + ch], cw1 = p.conv_w[(l * 4 + 1) * 512 + ch],
                  cw2 = p.conv_w[(l * 4 + 2) * 512 + ch], cw3 = p.conv_w[(l * 4 + 3) * 512 + ch];
      const float cb = p.conv_b[l * 512 + ch];
      float xv[19];
#pragma unroll
      for (int k = 0; k < 19; ++k) xv[k] = bf2f(xs[(qd * 16 + k) * 64 + e_]);
#pragma unroll
      for (int tt = 0; tt < 16; ++tt) {
        const int t = qd * 16 + tt;
        const float u = cb + xv[tt] * cw0 + xv[tt + 1] * cw1 + xv[tt + 2] * cw2 + xv[tt + 3] * cw3;
        u32[t * 64 + e_] = u;
        ub[t * 72 + e_] = (u16)f2bf(u);
      }
    }
    __syncthreads();
    if (FINAL) {
      *(uint4*)(xs + (tid >> 3) * 64 + (tid & 7) * 8) = gz0;
      *(uint4*)(xs + ((tid >> 3) + 32) * 64 + (tid & 7) * 8) = gz1;
    }
    float hsum[16];
#pragma unroll
    for (int tt = 0; tt < 16; ++tt) hsum[tt] = 0.f;
#pragma unroll
    for (int d = 0; d < 2; ++d) {
      {
        bf16x8 uf[2];
        uf[0] = *(const bf16x8*)(ub + (16 * w + l15) * 72 + g * 8);
        uf[1] = *(const bf16x8*)(ub + (16 * w + l15) * 72 + 32 + g * 8);
        const int t = 16 * w + l15;
#pragma unroll
        for (int et = 0; et < 4; ++et) {
          f32x4 ar = {0.f, 0.f, 0.f, 0.f}, ai = {0.f, 0.f, 0.f, 0.f};
          const u16* wr = p.WLRU + ((((size_t)(l * 2 + d) * 2 + 0) * 8 + nb) * 64 + et * 16 + l15) * 64 + g * 8;
          const u16* wi = p.WLRU + ((((size_t)(l * 2 + d) * 2 + 1) * 8 + nb) * 64 + et * 16 + l15) * 64 + g * 8;
#pragma unroll
          for (int ks = 0; ks < 2; ++ks) {
            ar = mfma16(*(const bf16x8*)(wr + ks * 32), uf[ks], ar);
            ai = mfma16(*(const bf16x8*)(wi + ks * 32), uf[ks], ai);
          }
          const int e0 = et * 16 + 4 * g, ch0 = nb * 64 + e0;
          const float4 ba4 = *(const float4*)(p.ba + (l * 2 + d) * 512 + ch0);
          const float4 bx4 = *(const float4*)(p.bx + (l * 2 + d) * 512 + ch0);
          const float4 sp4 = *(const float4*)(p.SP8 + (l * 2 + d) * 512 + ch0);
          const float4 uu = *(const float4*)(u32 + t * 64 + e0);
          const float* bap = (const float*)&ba4; const float* bxp = (const float*)&bx4;
          const float* spp = (const float*)&sp4; const float* uup = (const float*)&uu;
          f32x4 av, bv;
#pragma unroll
          for (int j = 0; j < 4; ++j) {
            float r = sigmoidf_(ar[j] + bap[j]);
            float ig = sigmoidf_(ai[j] + bxp[j]);
            float la = spp[j] * r;
            float av_ = __expf(la);
            float t2 = 2.0f * la;
            float ser = -t2 * (1.f + t2 * 0.5f * (1.f + t2 * (1.f / 3.f) * (1.f + t2 * 0.25f * (1.f + t2 * 0.2f))));
            float om = (t2 > -0.25f) ? ser : (1.0f - av_ * av_);
            av[j] = av_;
            bv[j] = __builtin_amdgcn_sqrtf(om) * ig * uup[j];
          }
          *(f32x4*)(sa + t * 64 + e0) = av;
          *(f32x4*)(sb + t * 64 + e0) = bv;
        }
      }
      __syncthreads();
      {
        float A = 1.f, B = 0.f;
        if (d == 0) {
#pragma unroll
          for (int tt = 0; tt < 16; ++tt) { int t = qd * 16 + tt; float a = sa[t * 64 + e_], b = sb[t * 64 + e_]; B = a * B + b; A *= a; }
        } else {
#pragma unroll
          for (int tt = 15; tt >= 0; --tt) { int t = qd * 16 + tt; float a = sa[t * 64 + e_], b = sb[t * 64 + e_]; B = a * B + b; A *= a; }
        }
        part[(0 * 4 + qd) * 64 + e_] = A;
        part[(1 * 4 + qd) * 64 + e_] = B;
      }
      __syncthreads();
      if (!FINAL) {
        if (qd == 0) {
          float A = 1.f, B = 0.f;
          if (d == 0) {
#pragma unroll
            for (int q = 0; q < 4; ++q) { float aq = part[q * 64 + e_], bq = part[(4 + q) * 64 + e_]; B = aq * B + bq; A *= aq; }
          } else {
#pragma unroll
            for (int q = 3; q >= 0; --q) { float aq = part[q * 64 + e_], bq = part[(4 + q) * 64 + e_]; B = aq * B + bq; A *= aq; }
          }
          const size_t cidx = ((size_t)ci * 2 + d) * 512 + nb * 64 + e_;
          p.CA[cidx] = A; p.CB[cidx] = B;
        }
      } else {
        float h = d ? cin1 : cin0;
        if (d == 0) {
#pragma unroll
          for (int q = 0; q < 4; ++q) if (q < qd) h = part[q * 64 + e_] * h + part[(4 + q) * 64 + e_];
#pragma unroll
          for (int tt = 0; tt < 16; ++tt) { int t = qd * 16 + tt; h = sa[t * 64 + e_] * h + sb[t * 64 + e_]; hsum[tt] += h; }
        } else {
#pragma unroll
          for (int q = 3; q >= 0; --q) if (q > qd) h = part[q * 64 + e_] * h + part[(4 + q) * 64 + e_];
#pragma unroll
          for (int tt = 15; tt >= 0; --tt) { int t = qd * 16 + tt; h = sa[t * 64 + e_] * h + sb[t * 64 + e_]; hsum[tt] += h; }
        }
      }
      __syncthreads();
    }
    if (FINAL) {
#pragma unroll
      for (int tt = 0; tt < 16; ++tt) {
        const int t = qd * 16 + tt;
        const float gzv = bf2f(xs[t * 64 + e_]);
        ub[t * 72 + e_] = (u16)f2bf(hsum[tt] * siluf_(gzv));
      }
      __syncthreads();
      u16* ob = p.ACT + (size_t)tb * DM + 256 + nb * 64 + (tid & 7) * 8;
      *(uint4*)(ob + (size_t)(tid >> 3) * DM) = *(const uint4*)(ub + (tid >> 3) * 72 + (tid & 7) * 8);
      *(uint4*)(ob + (size_t)((tid >> 3) + 32) * DM) = *(const uint4*)(ub + ((tid >> 3) + 32) * 72 + (tid & 7) * 8);
    }
  }
  __syncthreads();
}

__device__ void lru_scan_item(const Params& p, int item) {
  const int i = item * 256 + TIDX();
  const int seq = i >> 10, d = (i >> 9) & 1, ch = i & 511;
  int base, len; seq_info(seq, base, len);
  const int c0 = base >> 6, nc = len >> 6;
  float h = 0.f;
  for (int n0 = 0; n0 < nc; n0 += 16) {
    float a[16], b[16];
#pragma unroll
    for (int k = 0; k < 16; ++k) {
      const int n = d ? (nc - 1 - (n0 + k)) : (n0 + k);
      const size_t ix = ((size_t)(c0 + n) * 2 + d) * 512 + ch;
      a[k] = p.CA[ix]; b[k] = p.CB[ix];
    }
#pragma unroll
    for (int k = 0; k < 16; ++k) {
      const int n = d ? (nc - 1 - (n0 + k)) : (n0 + k);
      const size_t ix = ((size_t)(c0 + n) * 2 + d) * 512 + ch;
      p.CB[ix] = h; h = a[k] * h + b[k];
    }
  }
}

__device__ void hgrn_item(const Params& p, int l, int item, unsigned char* smem, bool dry = false) {
  float* LF = (float*)smem;
  u16* KKB = (u16*)(smem + 16384);
  u16* QH = (u16*)(smem + 25600);
  u16* QT = (u16*)(smem + 34816);
  u16* KHT = (u16*)(smem + 44032);
  u16* VTt = (u16*)(smem + 53248);
  u16* ST = (u16*)(smem + 62464);
  float* part = (float*)(smem + 71680);
  const int tid = TIDX(), lane = tid & 63, w = tid >> 6, l15 = lane & 15, g = lane >> 4;
  const int seq = item >> 3, h = (item >> 1) & 3, d = item & 1;
  int base, len; seq_info(seq, base, len);
  const int nc = len >> 6;
  const int r0 = tid >> 3, kc = tid & 7;
  const int cfslot = d ? C_HFB : C_HFF;
  float lbv[8];
#pragma unroll
  for (int e = 0; e < 8; ++e) {
    if (l == 0) lbv[e] = 0.f;
    else {
      float a1 = p.hg_lb[(1 * 2 + d) * 256 + 64 * h + 8 * kc + e], a0 = p.hg_lb[(0 * 2 + d) * 256 + 64 * h + 8 * kc + e];
      lbv[e] = sigmoidf_(a1 - a0);
    }
  }
  __syncthreads();
  for (int i = tid; i < 64 * 72 / 2; i += 256) ((unsigned*)ST)[i] = 0u;
  f32x4 Sacc[4];
#pragma unroll
  for (int vt = 0; vt < 4; ++vt) Sacc[vt] = f32x4{0.f, 0.f, 0.f, 0.f};
  uint4 rq[2], rf[2], rv[2];
#define HG_TOK(n, i) (d ? (base + len - 1 - ((n) * 64 + (i))) : (base + (n) * 64 + (i)))
#pragma unroll
  for (int s = 0; s < 2; ++s) {
    const u16* zr = p.Z + (size_t)HG_TOK(0, r0 + 32 * s) * DIN + 64 * h + 8 * kc;
    rq[s] = *(const uint4*)(zr + C_HQ); rf[s] = *(const uint4*)(zr + cfslot); rv[s] = *(const uint4*)(zr + C_HI);
  }
  for (int n = 0; n < nc; ++n) {
    float qs[2][8], kk[2][8];
    uint4 vraw[2];
#pragma unroll
    for (int s = 0; s < 2; ++s) {
      const int i = r0 + 32 * s;
      float zf[8], zq[8], lf[8];
      unpack8(rf[s], zf); unpack8(rq[s], zq);
      vraw[s] = rv[s];
#pragma unroll
      for (int e = 0; e < 8; ++e) {
        float sg = sigmoidf_(zf[e]);
        float f = lbv[e] + (1.f - lbv[e]) * sg;
        lf[e] = __logf(f);
        kk[s][e] = (1.f - lbv[e]) * (1.f - sg);
        qs[s][e] = siluf_(zq[e]);
      }
      *(float4*)(LF + i * 64 + 8 * kc) = make_float4(lf[0], lf[1], lf[2], lf[3]);
      *(float4*)(LF + i * 64 + 8 * kc + 4) = make_float4(lf[4], lf[5], lf[6], lf[7]);
      *(uint4*)(KKB + i * 72 + 8 * kc) = pack8(kk[s]);
    }
    if (n + 1 < nc) {
#pragma unroll
      for (int s = 0; s < 2; ++s) {
        const u16* zr = p.Z + (size_t)HG_TOK(n + 1, r0 + 32 * s) * DIN + 64 * h + 8 * kc;
        rq[s] = *(const uint4*)(zr + C_HQ); rf[s] = *(const uint4*)(zr + cfslot); rv[s] = *(const uint4*)(zr + C_HI);
      }
    }
    __syncthreads();
    {
      const int k = tid & 63, qd = tid >> 6;
      float s = 0.f;
#pragma unroll
      for (int tt = 0; tt < 16; ++tt) { int i = qd * 16 + tt; s += LF[i * 64 + k]; LF[i * 64 + k] = s; }
      part[qd * 64 + k] = s;
    }
    __syncthreads();
    {
      const int k = tid & 63, qd = tid >> 6;
      float off = 0.f;
#pragma unroll
      for (int q = 0; q < 3; ++q) if (q < qd) off += part[q * 64 + k];
      if (qd > 0) {
#pragma unroll
        for (int tt = 0; tt < 16; ++tt) { int i = qd * 16 + tt; LF[i * 64 + k] += off; }
      }
    }
    __syncthreads();
#pragma unroll
    for (int s = 0; s < 2; ++s) {
      const int i = r0 + 32 * s, I = i >> 4;
      float c8[8], cl8[8], cp8[8], qh[8], qt[8], vv[8];
      *(float4*)(c8) = *(const float4*)(LF + i * 64 + 8 * kc); *(float4*)(c8 + 4) = *(const float4*)(LF + i * 64 + 8 * kc + 4);
      *(float4*)(cl8) = *(const float4*)(LF + 63 * 64 + 8 * kc); *(float4*)(cl8 + 4) = *(const float4*)(LF + 63 * 64 + 8 * kc + 4);
      if (I > 0) {
        *(float4*)(cp8) = *(const float4*)(LF + (16 * I - 1) * 64 + 8 * kc); *(float4*)(cp8 + 4) = *(const float4*)(LF + (16 * I - 1) * 64 + 8 * kc + 4);
      } else {
#pragma unroll
        for (int e = 0; e < 8; ++e) cp8[e] = 0.f;
      }
      unpack8(vraw[s], vv);
#pragma unroll
      for (int e = 0; e < 8; ++e) {
        qt[e] = qs[s][e] * __expf(c8[e] - cp8[e]);
        qh[e] = qs[s][e] * __expf(c8[e]);
        KHT[(8 * kc + e) * 72 + i] = (u16)f2bf(kk[s][e] * __expf(cl8[e] - c8[e]));
        VTt[(8 * kc + e) * 72 + i] = (u16)f2bf(vv[e]);
      }
      *(uint4*)(QH + i * 72 + 8 * kc) = pack8(qh);
      *(uint4*)(QT + i * 72 + 8 * kc) = pack8(qt);
    }
    __syncthreads();
    float clw[4];
    {
      const int I = w;
      float cpI[2][8];
#pragma unroll
      for (int ks = 0; ks < 2; ++ks)
#pragma unroll
        for (int e = 0; e < 8; ++e) cpI[ks][e] = (I > 0) ? LF[(16 * I - 1) * 64 + 32 * ks + 8 * g + e] : 0.f;
#pragma unroll
      for (int j = 0; j < 4; ++j) clw[j] = LF[63 * 64 + 16 * w + 4 * g + j];
      f32x4 acc[4];
#pragma unroll
      for (int vt = 0; vt < 4; ++vt) acc[vt] = f32x4{0.f, 0.f, 0.f, 0.f};
      bf16x8 qtf[2];
#pragma unroll
      for (int ks = 0; ks < 2; ++ks) {
        bf16x8 qhf = *(const bf16x8*)(QH + (16 * I + l15) * 72 + 32 * ks + 8 * g);
        qtf[ks] = *(const bf16x8*)(QT + (16 * I + l15) * 72 + 32 * ks + 8 * g);
#pragma unroll
        for (int vt = 0; vt < 4; ++vt) {
          bf16x8 stf = *(const bf16x8*)(ST + (16 * vt + l15) * 72 + 32 * ks + 8 * g);
          acc[vt] = mfma16(stf, qhf, acc[vt]);
        }
      }
      unsigned pk[2][4];
#pragma unroll
      for (int a = 0; a < 2; ++a)
#pragma unroll
        for (int b = 0; b < 4; ++b) pk[a][b] = 0u;
#pragma unroll
      for (int J = 0; J < 4; ++J) {
        if (J <= I) {
          f32x4 sT = {0.f, 0.f, 0.f, 0.f};
#pragma unroll
          for (int ks = 0; ks < 2; ++ks) {
            uint4 kraw = *(const uint4*)(KKB + (16 * J + l15) * 72 + 32 * ks + 8 * g);
            float kx[8], cj[8];
            unpack8(kraw, kx);
            *(float4*)(cj) = *(const float4*)(LF + (16 * J + l15) * 64 + 32 * ks + 8 * g);
            *(float4*)(cj + 4) = *(const float4*)(LF + (16 * J + l15) * 64 + 32 * ks + 8 * g + 4);
#pragma unroll
            for (int e = 0; e < 8; ++e) kx[e] *= __expf(cpI[ks][e] - cj[e]);
            uint4 kf = pack8(kx);
            sT = mfma16(as_bf8(kf), qtf[ks], sT);
          }
          if (J == I) {
#pragma unroll
            for (int j = 0; j < 4; ++j) if (4 * g + j > l15) sT[j] = 0.f;
          }
          pk[J >> 1][(J & 1) * 2 + 0] = pack2(sT[0], sT[1]);
          pk[J >> 1][(J & 1) * 2 + 1] = pack2(sT[2], sT[3]);
        }
      }
#pragma unroll
      for (int kp = 0; kp < 2; ++kp) {
        if (kp <= (I >> 1)) {
          uint4 pv = make_uint4(pk[kp][0], pk[kp][1], pk[kp][2], pk[kp][3]);
#pragma unroll
          for (int vt = 0; vt < 4; ++vt) {
            uint2 a = *(const uint2*)(VTt + (16 * vt + l15) * 72 + 32 * kp + 4 * g);
            uint2 b = *(const uint2*)(VTt + (16 * vt + l15) * 72 + 32 * kp + 16 + 4 * g);
            uint4 vf = make_uint4(a.x, a.y, b.x, b.y);
            acc[vt] = mfma16(as_bf8(vf), as_bf8(pv), acc[vt]);
          }
        }
      }
      u16* orow = dry ? (p.ACT + (size_t)HG_TOK(n, 16 * I + l15) * DM + 64 * h) : (p.Z + (size_t)HG_TOK(n, 16 * I + l15) * DIN + cfslot + 64 * h);
#pragma unroll
      for (int vt = 0; vt < 4; ++vt) {
        uint2 o2; o2.x = pack2(acc[vt][0], acc[vt][1]); o2.y = pack2(acc[vt][2], acc[vt][3]);
        *(uint2*)(orow + 16 * vt + 4 * g) = o2;
      }
    }
    __syncthreads();
    {
      float dec[4];
#pragma unroll
      for (int j = 0; j < 4; ++j) dec[j] = __expf(clw[j]);
#pragma unroll
      for (int vt = 0; vt < 4; ++vt)
#pragma unroll
        for (int j = 0; j < 4; ++j) Sacc[vt][j] *= dec[j];
#pragma unroll
      for (int ks = 0; ks < 2; ++ks) {
        bf16x8 khf = *(const bf16x8*)(KHT + (16 * w + l15) * 72 + 32 * ks + 8 * g);
#pragma unroll
        for (int vt = 0; vt < 4; ++vt) {
          bf16x8 vtf = *(const bf16x8*)(VTt + (16 * vt + l15) * 72 + 32 * ks + 8 * g);
          Sacc[vt] = mfma16(khf, vtf, Sacc[vt]);
        }
      }
#pragma unroll
      for (int vt = 0; vt < 4; ++vt) {
        uint2 o2; o2.x = pack2(Sacc[vt][0], Sacc[vt][1]); o2.y = pack2(Sacc[vt][2], Sacc[vt][3]);
        *(uint2*)(ST + (16 * vt + l15) * 72 + 16 * w + 4 * g) = o2;
      }
    }
  }
#undef HG_TOK
  __syncthreads();
}

__device__ void phase_hgrn_combine(const Params& p, int l) {
  const int lane = TIDX() & 63;
  const int gw = BIDX() * 4 + (TIDX() >> 6), nw = gridDim.x * 4;
  const int hd = lane >> 4, sub = lane & 15;
  const float4 gn = *(const float4*)(p.hg_norm + l * 64 + 4 * sub);
  for (int t = gw; t < T_TOK; t += nw) {
    const u16* zr = p.Z + (size_t)t * DIN + 64 * hd + 4 * sub;
    typedef unsigned u2v __attribute__((ext_vector_type(2)));
    const u2v a_ = __builtin_nontemporal_load((const u2v*)(zr + C_HFF)), b_ = __builtin_nontemporal_load((const u2v*)(zr + C_HFB)),
              g_ = __builtin_nontemporal_load((const u2v*)(zr + C_HG));
    uint2 a = make_uint2(a_[0], a_[1]), b = make_uint2(b_[0], b_[1]), gz = make_uint2(g_[0], g_[1]);
    float o0 = lo_f(a.x) + lo_f(b.x), o1 = hi_f(a.x) + hi_f(b.x), o2 = lo_f(a.y) + lo_f(b.y), o3 = hi_f(a.y) + hi_f(b.y);
    float ss = o0 * o0 + o1 * o1 + o2 * o2 + o3 * o3;
#pragma unroll
    for (int o = 8; o >= 1; o >>= 1) ss += __shfl_xor(ss, o);
    float rs = rsqrtf(ss * (1.0f / 64.0f) + RMS_EPS);
    uint2 r;
    r.x = pack2_hw(o0 * rs * gn.x * siluf_(lo_f(gz.x)), o1 * rs * gn.y * siluf_(hi_f(gz.x)));
    r.y = pack2_hw(o2 * rs * gn.z * siluf_(lo_f(gz.y)), o3 * rs * gn.w * siluf_(hi_f(gz.y)));
    *(uint2*)(p.ACT + (size_t)t * DM + 64 * hd + 4 * sub) = r;
  }
}

__device__ void attn_item(const Params& p, int l, int item, unsigned char* smem) {
  const int tid = TIDX(), lane = tid & 63, w = tid >> 6, l15 = lane & 15, g = lane >> 4;
  int seq, h, qb;
  if (item < 2048) { seq = item >> 7; h = (item >> 5) & 3; qb = item & 31; }
  else { int id = item - 2048; seq = 16 + (id >> 6); h = (id >> 4) & 3; qb = id & 15; }
  int tb, len; seq_info(seq, tb, len);
  const int q0 = qb * 128 + 32 * w;
  const float SC = 0.17677669529663687f * 1.4426950408889634f;
  bf16x8 Qf[2][2];
  float cref[2][2];
#pragma unroll
  for (int hh = 0; hh < 2; ++hh)
#pragma unroll
    for (int qt = 0; qt < 2; ++qt) {
      const int qpos = q0 + 16 * qt + l15;
      uint4 raw = *(const uint4*)(p.Z + (size_t)(tb + qpos) * DIN + C_DQ + (2 * h + hh) * 32 + 8 * g);
      float x[8], y[8]; unpack8(raw, x);
      if (g == 0) {
        const float* rt = p.ROPE + (size_t)qpos * 8;
#pragma unroll
        for (int k = 0; k < 4; ++k) {
          float c = rt[2 * k], s = rt[2 * k + 1];
          y[k] = x[k] * c - x[k + 4] * s;
          y[k + 4] = x[k + 4] * c + x[k] * s;
        }
      } else {
#pragma unroll
        for (int k = 0; k < 8; ++k) y[k] = x[k];
      }
      float q2 = 0.f;
#pragma unroll
      for (int k = 0; k < 8; ++k) { y[k] *= SC; q2 += y[k] * y[k]; }
      q2 += __shfl_xor(q2, 16); q2 += __shfl_xor(q2, 32);
      cref[hh][qt] = sqrtf(q2 * __uint_as_float(p.KMAX[(l * 32 + seq) * 8 + 2 * h + hh])) * 1.02f;
      Qf[hh][qt] = as_bf8(pack8(y));
    }
  const bool fixedref = (__builtin_amdgcn_ballot_w64(fmaxf(fmaxf(cref[0][0], cref[0][1]), fmaxf(cref[1][0], cref[1][1])) > 40.0f) == 0);
  f32x4 O[2][4][2];
  float mrun[2][2];
  f32x4 Ol[2][2];
  const bf16x8 ones8 = as_bf8(make_uint4(0x3F803F80u, 0x3F803F80u, 0x3F803F80u, 0x3F803F80u));
#pragma unroll
  for (int hh = 0; hh < 2; ++hh)
#pragma unroll
    for (int qt = 0; qt < 2; ++qt) {
      mrun[hh][qt] = fixedref ? cref[hh][qt] : 0.f; Ol[hh][qt] = f32x4{0.f, 0.f, 0.f, 0.f};
#pragma unroll
      for (int dt = 0; dt < 4; ++dt) O[hh][dt][qt] = f32x4{0.f, 0.f, 0.f, 0.f};
    }
  const int nkt = len >> 6;
  const int srow = tid >> 3, sch = (tid & 7) * 8;
  const u16* gk = p.Z + (size_t)(tb + srow) * DIN + C_DK + 64 * h + sch;
  const u16* gv = p.VT + (size_t)(64 * h + srow) * T_TOK + tb + sch;
  u16* sbase = (u16*)smem;
  uint4 rk0, rk1, rv0, rv1;
  __syncthreads();
  rk0 = *(const uint4*)(gk);
  rk1 = *(const uint4*)(gk + (size_t)32 * DIN);
  rv0 = *(const uint4*)(gv);
  rv1 = *(const uint4*)(gv + (size_t)32 * T_TOK);
  *(uint4*)(sbase + srow * 72 + sch) = rk0;
  *(uint4*)(sbase + (srow + 32) * 72 + sch) = rk1;
  *(uint4*)(sbase + 64 * 72 + srow * 72 + sch) = rv0;
  *(uint4*)(sbase + 64 * 72 + (srow + 32) * 72 + sch) = rv1;
  __syncthreads();
  for (int kt = 0; kt < nkt; ++kt) {
    const int cur = kt & 1;
    const bool more = (kt + 1 < nkt);
    if (more) {
      rk0 = *(const uint4*)(gk + (size_t)((kt + 1) * 64) * DIN);
      rk1 = *(const uint4*)(gk + (size_t)((kt + 1) * 64 + 32) * DIN);
      rv0 = *(const uint4*)(gv + (kt + 1) * 64);
      rv1 = *(const uint4*)(gv + (size_t)32 * T_TOK + (kt + 1) * 64);
    }
    __builtin_amdgcn_sched_barrier(0);
    const u16* KS = sbase + cur * (2 * 64 * 72);
    const u16* VS = KS + 64 * 72;
#pragma unroll
    for (int hh = 0; hh < 2; ++hh) {
      bf16x8 Pf[2][2];
      f32x4 st[4][2];
      {
        f32x4 ci0, ci1;
        ci0[0] = ci0[1] = ci0[2] = ci0[3] = -mrun[hh][0];
        ci1[0] = ci1[1] = ci1[2] = ci1[3] = -mrun[hh][1];
#pragma unroll
        for (int k4 = 0; k4 < 4; ++k4) {
          bf16x8 kf = *(const bf16x8*)(KS + (16 * k4 + l15) * 72 + 32 * hh + 8 * g);
          st[k4][0] = mfma16(kf, Qf[hh][0], ci0);
          st[k4][1] = mfma16(kf, Qf[hh][1], ci1);
        }
      }
      __builtin_amdgcn_sched_barrier(0);
      if (!fixedref) {
      float mx[2];
#pragma unroll
      for (int qt = 0; qt < 2; ++qt) {
        float m_ = st[0][qt][0];
#pragma unroll
        for (int k4 = 0; k4 < 4; ++k4)
#pragma unroll
          for (int j = 0; j < 4; ++j) m_ = fmaxf(m_, st[k4][qt][j]);
        m_ = fmaxf(m_, __shfl_xor(m_, 16));
        m_ = fmaxf(m_, __shfl_xor(m_, 32));
        mx[qt] = m_;
      }
      const bool upd = (kt == 0) || (__builtin_amdgcn_ballot_w64(fmaxf(mx[0], mx[1]) > 8.0f) != 0);
      if (upd) {
#pragma unroll
        for (int qt = 0; qt < 2; ++qt) {
          const float delta = (kt == 0 || mx[qt] > 8.0f) ? mx[qt] : 0.f;
          mrun[hh][qt] += delta;
          const float alpha = __builtin_amdgcn_exp2f(-delta);
#pragma unroll
          for (int j = 0; j < 4; ++j) Ol[hh][qt][j] *= alpha;
#pragma unroll
          for (int dt = 0; dt < 4; ++dt)
#pragma unroll
            for (int j = 0; j < 4; ++j) O[hh][dt][qt][j] *= alpha;
#pragma unroll
          for (int k4 = 0; k4 < 4; ++k4)
#pragma unroll
            for (int j = 0; j < 4; ++j) st[k4][qt][j] -= delta;
        }
      }
      }
#pragma unroll
      for (int qt = 0; qt < 2; ++qt) {
#pragma unroll
        for (int k4 = 0; k4 < 4; ++k4)
#pragma unroll
          for (int j = 0; j < 4; ++j) st[k4][qt][j] = __builtin_amdgcn_exp2f(st[k4][qt][j]);
#pragma unroll
        for (int ks = 0; ks < 2; ++ks) {
          uint4 pk;
          pk.x = pack2_hw(st[2 * ks][qt][0], st[2 * ks][qt][1]); pk.y = pack2_hw(st[2 * ks][qt][2], st[2 * ks][qt][3]);
          pk.z = pack2_hw(st[2 * ks + 1][qt][0], st[2 * ks + 1][qt][1]); pk.w = pack2_hw(st[2 * ks + 1][qt][2], st[2 * ks + 1][qt][3]);
          Pf[qt][ks] = as_bf8(pk);
          Ol[hh][qt] = mfma16(ones8, Pf[qt][ks], Ol[hh][qt]);
        }
        __builtin_amdgcn_sched_barrier(0);
      }
#pragma unroll
    for (int dt = 0; dt < 4; ++dt) {
      bf16x8 Vf[2];
#pragma unroll
      for (int ks = 0; ks < 2; ++ks) {
        uint2 a = *(const uint2*)(VS + (16 * dt + l15) * 72 + 32 * ks + 4 * g);
        uint2 b = *(const uint2*)(VS + (16 * dt + l15) * 72 + 32 * ks + 16 + 4 * g);
        Vf[ks] = as_bf8(make_uint4(a.x, a.y, b.x, b.y));
      }
#pragma unroll
        for (int qt = 0; qt < 2; ++qt)
#pragma unroll
          for (int ks = 0; ks < 2; ++ks) O[hh][dt][qt] = mfma16(Vf[ks], Pf[qt][ks], O[hh][dt][qt]);
    }
    }
    __builtin_amdgcn_sched_barrier(0);
    if (more) {
      u16* nb_ = sbase + (cur ^ 1) * (2 * 64 * 72);
      *(uint4*)(nb_ + srow * 72 + sch) = rk0;
      *(uint4*)(nb_ + (srow + 32) * 72 + sch) = rk1;
      *(uint4*)(nb_ + 64 * 72 + srow * 72 + sch) = rv0;
      *(uint4*)(nb_ + 64 * 72 + (srow + 32) * 72 + sch) = rv1;
    }
    __syncthreads();
  }
  float s1 = 0.f, s2 = 0.f;
  for (int k = 0; k < 32; ++k) { s1 += p.lq1[l * 32 + k] * p.lk1[l * 32 + k]; s2 += p.lq2[l * 32 + k] * p.lk2[l * 32 + k]; }
  const float lam_init = (l == 0) ? 0.2f : (0.8f - 0.6f * 0.74081822068171788f);
  const float lam = __expf(s1) - __expf(s2) + lam_init;
#pragma unroll
  for (int qt = 0; qt < 2; ++qt) {
    const float l0 = Ol[0][qt][0], l1 = Ol[1][qt][0];
    const float i0 = 1.0f / l0, i1 = lam / l1;
    float o[4][4];
    float ss = 0.f;
#pragma unroll
    for (int dt = 0; dt < 4; ++dt)
#pragma unroll
      for (int j = 0; j < 4; ++j) { o[dt][j] = O[0][dt][qt][j] * i0 - O[1][dt][qt][j] * i1; ss += o[dt][j] * o[dt][j]; }
    ss += __shfl_xor(ss, 16); ss += __shfl_xor(ss, 32);
    const float rs = rsqrtf(ss * (1.0f / 64.0f) + RMS_EPS) * (1.0f - lam_init);
    const int t = tb + q0 + 16 * qt + l15;
#pragma unroll
    for (int dt = 0; dt < 4; ++dt) {
      const int dd = 16 * dt + 4 * g;
      typedef unsigned u2v __attribute__((ext_vector_type(2)));
      const u2v gz_ = __builtin_nontemporal_load((const u2v*)(p.Z + (size_t)t * DIN + C_DG + 64 * h + dd));
      uint2 gz = make_uint2(gz_[0], gz_[1]);
      float4 gn = *(const float4*)(p.da_norm + l * 64 + dd);
      uint2 r;
      r.x = pack2_hw(o[dt][0] * rs * gn.x * siluf_(lo_f(gz.x)), o[dt][1] * rs * gn.y * siluf_(hi_f(gz.x)));
      r.y = pack2_hw(o[dt][2] * rs * gn.z * siluf_(lo_f(gz.y)), o[dt][3] * rs * gn.w * siluf_(hi_f(gz.y)));
      *(uint2*)(p.ACT + (size_t)t * DM + 768 + 64 * h + dd) = r;
    }
  }
}

__device__ void run_phase(const Params& p, int ph, unsigned char* smem) {
  if (ph == 0) { phase_prep(p, smem); return; }
  if (ph == NPHASE - 1) { phase_norm(p, 0, true); return; }
  const int l = (ph - 1) / 7, s = (ph - 1) % 7;
  switch (s) {
    case 0: phase_norm(p, l, false); break;
    case 1: phase_gemm_in(p, l, smem);
#if PROBE_DUP == 1
      phase_gemm_in(p, l, smem);
#endif
      break;
    case 2:
      phase_krope(p, l);
      phase_lru<false>(p, l, smem);
      break;
    case 3: {
      int* slot = (int*)(smem + 73728);
      for (;;) {
        __syncthreads();
        if (TIDX() == 0) *slot = (int)atomicAdd(p.CTR + l, 1u);
        __syncthreads();
        const int it = *slot;
#if PROBE_DUP == 4
        if (it >= 256 + 128 + 3072 * 2) break;
#else
        if (it >= 256 + 128 + 3072) break;
#endif
        if (it < 256) hgrn_item(p, l, it, smem);
        else if (it < 256 + 3072) attn_item(p, l, it - 256, smem);
        else lru_scan_item(p, it - 256 - 3072);
      }
      break;
    }
    case 4:
      phase_lru<true>(p, l, smem);
      phase_hgrn_combine(p, l);
#if PROBE_DUP == 5
      phase_lru<true>(p, l, smem);
#endif
#if PROBE_DUP == 15
      phase_hgrn_combine(p, l);
      phase_hgrn_combine(p, l);
      phase_hgrn_combine(p, l);
      phase_hgrn_combine(p, l);
#endif
      break;
    case 5: phase_gemm_out(p, l, smem); break;
    case 6: phase_gemm_ple(p, l, smem); break;
  }
}


#define XB_TMO      128
#define XB_XCNT(j)  (256  + 64 * (j))
#define XB_XSUB(j)  (1280 + 64 * (j))
#define XB_XGEN(j)  (2304 + 64 * (j))
#define XB_TOP      3328
#define XB_TOPGEN   3392
#define XCD_BAR_WORDS 3456
#define XB_SPIN_CAP (1u << 18)
#define LAS __attribute__((address_space(3)))
__device__ __forceinline__ unsigned xb_ld(unsigned* p)              { return __hip_atomic_load(p, __ATOMIC_RELAXED, __HIP_MEMORY_SCOPE_AGENT); }
__device__ __forceinline__ unsigned xb_add(unsigned* p, unsigned v) { return __hip_atomic_fetch_add(p, v, __ATOMIC_RELAXED, __HIP_MEMORY_SCOPE_AGENT); }
__device__ __forceinline__ unsigned xb_xcc_id() { return (unsigned)__builtin_amdgcn_s_getreg((3 << 11) | 20) & 0xFu; }
#define XB_SPIN(cond, bar) do { unsigned _sp = 0; while (cond) { __builtin_amdgcn_s_sleep(1); \
    if ((++_sp & 255u) == 0u) { if (xb_ld(&(bar)[XB_TMO])) break; if (_sp > XB_SPIN_CAP) { atomicAdd(&(bar)[XB_TMO], 1u); break; } } } } while (0)
struct XcdBarrier { unsigned* bar; unsigned x; volatile LAS unsigned* st; };
__device__ __forceinline__ XcdBarrier xcd_barrier_post(unsigned* bar, volatile LAS unsigned* st) {
  XcdBarrier b; b.bar = bar; b.x = xb_xcc_id(); b.st = st;
  if (threadIdx.x == 0) (void)xb_add(&bar[XB_XCNT(b.x)], 1u);
  return b;
}
__device__ __forceinline__ void xcd_barrier_complete(unsigned* bar, unsigned x, unsigned& nloc, unsigned& nx) {
  const unsigned G = gridDim.x * gridDim.y * gridDim.z;
  unsigned sum, cnt, mine, sp = 0u;
  for (;;) {
    sum = 0u; cnt = 0u; mine = 0u;
#pragma unroll
    for (unsigned j = 0; j < 16; ++j) { const unsigned c = xb_ld(&bar[XB_XCNT(j)]); sum += c; cnt += (c > 0u) ? 1u : 0u; mine = (j == x) ? c : mine; }
    if (sum == G) break;
    __builtin_amdgcn_s_sleep(1);
    if ((++sp & 255u) == 0u) { if (xb_ld(&bar[XB_TMO])) break; if (sp > XB_SPIN_CAP) { atomicAdd(&bar[XB_TMO], 1u); break; } }
  }
  nloc = mine > 0u ? mine : 1u; nx = cnt > 0u ? cnt : 1u;
}
__device__ __forceinline__ void xcd_barrier(const XcdBarrier& b) {
  asm volatile("s_waitcnt vmcnt(0)" ::: "memory");
  __syncthreads();
  if (threadIdx.x == 0) {
    unsigned* bar = b.bar;
    __builtin_amdgcn_s_waitcnt(0);
    unsigned nloc = b.st[0], nx = b.st[1];
    if (nloc == 0u) { xcd_barrier_complete(bar, b.x, nloc, nx); b.st[0] = nloc; b.st[1] = nx; }
    const unsigned old = xb_add(&bar[XB_XSUB(b.x)], 1u);
    const unsigned gen = old / nloc;
    if (old + 1u == (gen + 1u) * nloc) {
      __builtin_amdgcn_fence(__ATOMIC_RELEASE, "agent");
      asm volatile("s_waitcnt vmcnt(0)" ::: "memory");
      const unsigned og = xb_add(&bar[XB_TOP], 1u);
      const unsigned tg = og / nx;
      if (og + 1u == (tg + 1u) * nx) xb_add(&bar[XB_TOPGEN], 1u);
      else XB_SPIN(xb_ld(&bar[XB_TOPGEN]) == tg, bar);
      __builtin_amdgcn_fence(__ATOMIC_ACQUIRE, "agent");
      xb_add(&bar[XB_XGEN(b.x)], 1u);
      asm volatile("s_waitcnt vmcnt(0)" ::: "memory");
    } else {
      XB_SPIN(xb_ld(&bar[XB_XGEN(b.x)]) == gen, bar);
      __builtin_amdgcn_fence(__ATOMIC_ACQUIRE, "agent");
      asm volatile("s_waitcnt vmcnt(0)" ::: "memory");
    }
  }
  __syncthreads();
}

__global__ void __launch_bounds__(256, 2) mega(Params p) {
  extern __shared__ __attribute__((aligned(16))) unsigned char smem[];
  cg::grid_group grid = cg::this_grid();
  const bool multi = (p.phase_hi - p.phase_lo) > 1;
  XcdBarrier xb; xb.bar = p.BAR; xb.x = 0; xb.st = (volatile LAS unsigned*)(smem + 73736);
  if (multi) {
    if (threadIdx.x == 0) { xb.st[0] = 0u; xb.st[1] = 0u; }
    __syncthreads();
    xb = xcd_barrier_post(p.BAR, xb.st);
  }
  for (int ph = p.phase_lo; ph < p.phase_hi; ++ph) {
    if (ph > p.phase_lo) {
      if (ph == p.phase_lo + 1) grid.sync();
      else xcd_barrier(xb);
    }
    run_phase(p, ph, smem);
  }
}

extern "C" void kernel_launch(void* const* d_in, const int* in_sizes, int n_in, void* d_out, int out_size,
                              void* d_ws, size_t ws_size, hipStream_t stream) {
  static int grid_blocks = 0;
  if (!grid_blocks) {
    int dev = 0, cus = 0, per_cu = 0;
    hipGetDevice(&dev);
    hipDeviceGetAttribute(&cus, hipDeviceAttributeMultiprocessorCount, dev);
    hipFuncSetAttribute((const void*)mega, hipFuncAttributeMaxDynamicSharedMemorySize, LDS_BYTES);
    hipOccupancyMaxActiveBlocksPerMultiprocessor(&per_cu, (const void*)mega, 256, LDS_BYTES);
    if (per_cu < 1) per_cu = 1;
    if (per_cu > 2) per_cu = 2;
    grid_blocks = cus * per_cu;
  }
  Params p{};
  const float** fp = (const float**)&p;
  for (int i = 0; i < 24; ++i) fp[i] = (const float*)d_in[i];
  p.out = (float*)d_out;
  unsigned char* ws = (unsigned char*)d_ws;
  size_t off = 0;
  auto take = [&](size_t bytes) { unsigned char* r = ws + off; off += (bytes + 255) & ~(size_t)255; return r; };
  p.Z = (u16*)take((size_t)T_TOK * DIN * 2);
  p.ACT = (u16*)take((size_t)T_TOK * DM * 2);
  p.VT = (u16*)take((size_t)256 * T_TOK * 2);
  p.PB = (u16*)take((size_t)T_TOK * 256 * 2);
  p.CA = (float*)take((size_t)NCHUNK * 2 * 512 * 4);
  p.CB = (float*)take((size_t)NCHUNK * 2 * 512 * 4);
  p.WIN = (u16*)take((size_t)2 * DIN * DM * 2);
  p.WOUT = (u16*)take((size_t)2 * DM * DM * 2);
  p.WGATE = (u16*)take((size_t)2 * DM * DM * 2);
  p.WPLE = (u16*)take((size_t)2 * DM * 256 * 2);
  p.WLRU = (u16*)take((size_t)2 * 2 * 2 * 8 * 4096 * 2);
  p.ROPE = (float*)take((size_t)4096 * 8 * 4);
  p.SP8 = (float*)take((size_t)2 * 2 * 512 * 4);
  p.CTR = (unsigned*)take(256);
  p.KMAX = (unsigned*)take(2 * 256 * 4);
  p.BAR = (unsigned*)take((size_t)XCD_BAR_WORDS * 4);
  if (off > ws_size) { fprintf(stderr, "workspace too small: need %zu have %zu\n", off, ws_size); return; }
#if COOP
  p.phase_lo = 0; p.phase_hi = NPHASE;
  (void)hipMemsetAsync(p.BAR, 0, (size_t)XCD_BAR_WORDS * 4, stream);
  void* args[] = {&p};
  hipError_t e = hipLaunchCooperativeKernel((const void*)mega, dim3(grid_blocks), dim3(256), args, LDS_BYTES, stream);
  if (e != hipSuccess) fprintf(stderr, "cooperative launch failed: %s (grid %d)\n", hipGetErrorString(e), grid_blocks);
#else
  for (int ph = 0; ph < NPHASE; ++ph) {
    p.phase_lo = ph; p.phase_hi = ph + 1;
    hipLaunchKernelGGL(mega, dim3(grid_blocks), dim3(256), LDS_BYTES, stream, p);
  }
#endif
}
```

```cpp
#include <hip/hip_runtime.h>
#include <hip/hip_cooperative_groups.h>
#include <cstdio>
namespace cg = cooperative_groups;

#ifndef PROBE_DUP
#define PROBE_DUP 0
#endif
#ifndef COOP
#define COOP 1
#endif

typedef unsigned short u16;
typedef __attribute__((ext_vector_type(8))) short bf16x8;
typedef __attribute__((ext_vector_type(4))) float f32x4;

constexpr int T_TOK = 98304;
constexpr int T_PROMPT = 65536;
constexpr int DM = 1024;
constexpr int DIN = 3328;
constexpr int C_HQ = 0, C_HFF = 256, C_HFB = 512, C_HI = 768, C_HG = 1024, C_LX = 1280, C_LG = 1792,
              C_DQ = 2304, C_DK = 2560, C_DV = 2816, C_DG = 3072;
constexpr int NCHUNK = T_TOK / 64;
constexpr int LDS_BYTES = 73728 + 16;
constexpr int NPHASE = 1 + 7 * 2 + 1;
constexpr float RMS_EPS = 1e-6f;

struct Params {
  const float* x_prompt; const float* x_sample; const float* p_prompt; const float* p_sample;
  const float* norm_g; const float* w_in; const float* w_out; const float* hg_lb; const float* hg_norm;
  const float* conv_w; const float* conv_b; const float* wa; const float* ba; const float* wx; const float* bx;
  const float* lru_lam; const float* lq1; const float* lk1; const float* lq2; const float* lk2;
  const float* da_norm; const float* ple_w; const float* gate_w; const float* final_norm;
  float* out;
  u16* Z; u16* ACT; u16* VT; u16* PB; float* CA; float* CB;
  u16* WIN; u16* WOUT; u16* WGATE; u16* WPLE; u16* WLRU; float* ROPE; float* SP8; unsigned* CTR; unsigned* BAR; unsigned* KMAX;
  int phase_lo; int phase_hi;
};

__device__ __forceinline__ int TIDX() { int t = threadIdx.x; asm volatile("" : "+v"(t)); return t; }
__device__ __forceinline__ int BIDX() { int b = blockIdx.x; asm volatile("" : "+s"(b)); return b; }
__device__ __forceinline__ float bf2f(unsigned h) { return __uint_as_float(h << 16); }
__device__ __forceinline__ unsigned f2bf(float f) {
  return (unsigned)__builtin_bit_cast(unsigned short, (__bf16)f);
}
typedef __bf16 bf16x2_t __attribute__((ext_vector_type(2)));
typedef float f32x2_t __attribute__((ext_vector_type(2)));
__device__ __forceinline__ unsigned pack2(float a, float b) {
  f32x2_t v = {a, b};
  bf16x2_t r = __builtin_convertvector(v, bf16x2_t);
  return __builtin_bit_cast(unsigned, r);
}
__device__ __forceinline__ unsigned pack2_hw(float a, float b) { return pack2(a, b); }
__device__ __forceinline__ float lo_f(unsigned w) { return __uint_as_float(w << 16); }
__device__ __forceinline__ float hi_f(unsigned w) { return __uint_as_float(w & 0xffff0000u); }
__device__ __forceinline__ void unpack8(const uint4& v, float* x) {
  x[0] = lo_f(v.x); x[1] = hi_f(v.x); x[2] = lo_f(v.y); x[3] = hi_f(v.y);
  x[4] = lo_f(v.z); x[5] = hi_f(v.z); x[6] = lo_f(v.w); x[7] = hi_f(v.w);
}
__device__ __forceinline__ uint4 pack8(const float* x) {
  uint4 v; v.x = pack2_hw(x[0], x[1]); v.y = pack2_hw(x[2], x[3]); v.z = pack2_hw(x[4], x[5]); v.w = pack2_hw(x[6], x[7]);
  return v;
}
__device__ __forceinline__ bf16x8 as_bf8(const uint4& v) { return __builtin_bit_cast(bf16x8, v); }
__device__ __forceinline__ float sigmoidf_(float x) { return __builtin_amdgcn_rcpf(1.0f + __expf(-x)); }
__device__ __forceinline__ float siluf_(float x) { return x * __builtin_amdgcn_rcpf(1.0f + __expf(-x)); }
__device__ __forceinline__ f32x4 mfma16(bf16x8 a, bf16x8 b, f32x4 c) {
  return __builtin_amdgcn_mfma_f32_16x16x32_bf16(a, b, c, 0, 0, 0);
}
__device__ __forceinline__ int tok_pos(int t) { return t < T_PROMPT ? (t & 4095) : ((t - T_PROMPT) & 2047); }
__device__ __forceinline__ int tok_len(int t) { return t < T_PROMPT ? 4096 : 2048; }
__device__ __forceinline__ void seq_info(int seq, int& base, int& len) {
  if (seq < 16) { base = seq << 12; len = 4096; } else { base = T_PROMPT + ((seq - 16) << 11); len = 2048; }
}
__device__ __forceinline__ const float* x_row(const Params& p, int t) {
  return t < T_PROMPT ? p.x_prompt + (size_t)t * DM : p.x_sample + (size_t)(t - T_PROMPT) * DM;
}
__device__ __forceinline__ const float* p_row(const Params& p, int l, int t) {
  return t < T_PROMPT ? p.p_prompt + ((size_t)l * T_PROMPT + t) * 256
                      : p.p_sample + ((size_t)l * (T_TOK - T_PROMPT) + (t - T_PROMPT)) * 256;
}

struct TileIter { int v, end, step; };
__device__ __forceinline__ TileIter tile_iter(int NT) {
  int G = gridDim.x;
  TileIter it;
  if (G & 7) { it.v = BIDX(); it.end = NT; it.step = G; return it; }
  int per = (NT + 7) >> 3; int x = BIDX() & 7;
  it.v = x * per + (BIDX() >> 3); it.end = min((x + 1) * per, NT); it.step = G >> 3;
  return it;
}

__device__ void transpose_tile(const float* __restrict__ src, u16* __restrict__ dst, int K, int N, int tile, float* sm) {
  const int tid = TIDX();
  const int ntn = N >> 6;
  const int k0 = (tile / ntn) << 6, n0 = (tile % ntn) << 6;
  __syncthreads();
#pragma unroll
  for (int i = 0; i < 16; ++i) {
    int k = (tid >> 6) + 4 * i, n = tid & 63;
    sm[k * 65 + n] = src[(size_t)(k0 + k) * N + n0 + n];
  }
  __syncthreads();
#pragma unroll
  for (int i = 0; i < 16; ++i) {
    int n = (tid >> 6) + 4 * i, k = tid & 63;
    dst[(size_t)(n0 + n) * K + k0 + k] = (u16)f2bf(sm[k * 65 + n]);
  }
}

__device__ void phase_prep(const Params& p, unsigned char* smem) {
  float* sm = (float*)smem;
  for (int it = BIDX(); it < 2 * 1408; it += gridDim.x) {
    int l = it / 1408, r = it % 1408;
    if (r < 832) transpose_tile(p.w_in + (size_t)l * DM * DIN, p.WIN + (size_t)l * DIN * DM, DM, DIN, r, sm);
    else if (r < 1088) transpose_tile(p.w_out + (size_t)l * DM * DM, p.WOUT + (size_t)l * DM * DM, DM, DM, r - 832, sm);
    else if (r < 1344) transpose_tile(p.gate_w + (size_t)l * DM * DM, p.WGATE + (size_t)l * DM * DM, DM, DM, r - 1088, sm);
    else transpose_tile(p.ple_w + (size_t)l * 256 * DM, p.WPLE + (size_t)l * DM * 256, 256, DM, r - 1344, sm);
  }
  const int gt = BIDX() * 256 + TIDX(), gn = gridDim.x * 256;
  if (gt < 64) p.CTR[gt] = 0u;
  if (gt < 512) p.KMAX[gt] = 0u;
  for (int i = gt; i < 4096 * 4; i += gn) {
    int pos = i >> 2, k = i & 3;
    float inv = (k == 0) ? 1.0f : (k == 1) ? 0.037606030930863934f : (k == 2) ? 0.0014142135623730950f : 5.3183006600460594e-05f;
    float ang = (float)pos * inv;
    float nrev = rintf(ang * 0.15915494309189535f);
    float r = fmaf(-nrev, 6.28318548202514648f, ang);
    r = fmaf(-nrev, -1.74845553e-07f, r);
    p.ROPE[2 * i] = __cosf(r);
    p.ROPE[2 * i + 1] = __sinf(r);
  }
  for (int i = gt; i < 2 * 2 * 512; i += gn) {
    float nl = -p.lru_lam[i];
    p.SP8[i] = -8.0f * (fmaxf(nl, 0.f) + log1pf(__expf(-fabsf(nl))));
  }
  for (int i = gt; i < 2 * 2 * 2 * 8 * 4096; i += gn) {
    int c = i & 63, e = (i >> 6) & 63, blk = (i >> 12) & 7, mat = (i >> 15) & 1, d = (i >> 16) & 1, l = (i >> 17) & 1;
    const float* src = mat ? p.wx : p.wa;
    p.WLRU[i] = (u16)f2bf(src[((((size_t)(l * 2 + d) * 8 + blk) * 64 + c) * 64) + e]);
  }
}

__device__ void phase_norm(const Params& p, int l, bool fin) {
  const int lane = TIDX() & 63;
  const int gw = BIDX() * 4 + (TIDX() >> 6), nw = gridDim.x * 4;
  const float* g = fin ? p.final_norm : p.norm_g + l * DM;
  float4 gg[4];
#pragma unroll
  for (int i = 0; i < 4; ++i) gg[i] = ((const float4*)g)[lane + 64 * i];
  for (int row = gw; row < T_TOK; row += 2 * nw) {
    const int row2 = row + nw;
    const bool has2 = row2 < T_TOK;
    const float* src = (l == 0 && !fin) ? x_row(p, row) : p.out + (size_t)row * DM;
    const float* src2 = has2 ? ((l == 0 && !fin) ? x_row(p, row2) : p.out + (size_t)row2 * DM) : src;
    float4 v[4], u[4];
#pragma unroll
    for (int i = 0; i < 4; ++i) {
      typedef float f4v __attribute__((ext_vector_type(4)));
      const f4v a = __builtin_nontemporal_load((const f4v*)src + lane + 64 * i);
      const f4v b = __builtin_nontemporal_load((const f4v*)src2 + lane + 64 * i);
      v[i] = make_float4(a[0], a[1], a[2], a[3]); u[i] = make_float4(b[0], b[1], b[2], b[3]);
    }
    float ss = 0.f, ss2 = 0.f;
#pragma unroll
    for (int i = 0; i < 4; ++i) {
      ss += v[i].x * v[i].x + v[i].y * v[i].y + v[i].z * v[i].z + v[i].w * v[i].w;
      ss2 += u[i].x * u[i].x + u[i].y * u[i].y + u[i].z * u[i].z + u[i].w * u[i].w;
    }
#pragma unroll
    for (int o = 32; o >= 1; o >>= 1) { ss += __shfl_xor(ss, o); ss2 += __shfl_xor(ss2, o); }
    const float rs = rsqrtf(ss * (1.0f / 1024.0f) + RMS_EPS), rs2 = rsqrtf(ss2 * (1.0f / 1024.0f) + RMS_EPS);
#pragma unroll
    for (int i = 0; i < 4; ++i) {
      float4 y; y.x = v[i].x * rs * gg[i].x; y.y = v[i].y * rs * gg[i].y; y.z = v[i].z * rs * gg[i].z; y.w = v[i].w * rs * gg[i].w;
      float4 y2; y2.x = u[i].x * rs2 * gg[i].x; y2.y = u[i].y * rs2 * gg[i].y; y2.z = u[i].z * rs2 * gg[i].z; y2.w = u[i].w * rs2 * gg[i].w;
      if (fin) {
        typedef float f4v __attribute__((ext_vector_type(4)));
        const f4v ya = {y.x, y.y, y.z, y.w}, yb = {y2.x, y2.y, y2.z, y2.w};
        __builtin_nontemporal_store(ya, (f4v*)(p.out + (size_t)row * DM) + lane + 64 * i);
        if (has2) __builtin_nontemporal_store(yb, (f4v*)(p.out + (size_t)row2 * DM) + lane + 64 * i);
      } else {
        uint2 o2; o2.x = pack2_hw(y.x, y.y); o2.y = pack2_hw(y.z, y.w); ((uint2*)(p.ACT + (size_t)row * DM))[lane + 64 * i] = o2;
        if (has2) { uint2 o3; o3.x = pack2_hw(y2.x, y2.y); o3.y = pack2_hw(y2.z, y2.w); ((uint2*)(p.ACT + (size_t)row2 * DM))[lane + 64 * i] = o3; }
      }
    }
  }
  if (!fin) {
    const int total = T_TOK * 64;
    for (int i = BIDX() * 256 + TIDX(); i < total; i += gridDim.x * 256) {
      int t = i >> 6, c4 = i & 63;
      typedef float f4v __attribute__((ext_vector_type(4)));
      const f4v pv4 = __builtin_nontemporal_load((const f4v*)p_row(p, l, t) + c4);
      float4 v = make_float4(pv4[0], pv4[1], pv4[2], pv4[3]);
      uint2 o2; o2.x = pack2_hw(v.x, v.y); o2.y = pack2_hw(v.z, v.w);
      ((uint2*)(p.PB + (size_t)t * 256))[c4] = o2;
    }
  }
}

template <int NT>
__device__ __forceinline__ void gemm_mainloop(const u16* __restrict__ A, int lda, const u16* __restrict__ B, int ldb,
                                              int K, f32x4 (&acc)[4][NT], u16* sm) {
  static_assert(NT == 4, "only NT=4");
  const int tid = TIDX(), lane = tid & 63, w = tid >> 6, wm = w >> 1, wn = w & 1, l15 = lane & 15, g = lane >> 4;
  u16* sA = sm; u16* sB = sm + 2 * 128 * 72;
  const int lr = tid >> 3, lc = (tid & 7) * 8;
  const u16* ga = A + (size_t)lr * lda + lc;
  const u16* gb = B + (size_t)lr * ldb + lc;
  const size_t sa32 = (size_t)32 * lda, sb32 = (size_t)32 * ldb;
  uint4 ra0, ra1, ra2, ra3, rb0, rb1, rb2, rb3;
  ra0 = *(const uint4*)(ga); ra1 = *(const uint4*)(ga + sa32); ra2 = *(const uint4*)(ga + 2 * sa32); ra3 = *(const uint4*)(ga + 3 * sa32);
  rb0 = *(const uint4*)(gb); rb1 = *(const uint4*)(gb + sb32); rb2 = *(const uint4*)(gb + 2 * sb32); rb3 = *(const uint4*)(gb + 3 * sb32);
  {
    u16* wA = sA + lr * 72 + lc; u16* wB = sB + lr * 72 + lc;
    *(uint4*)(wA) = ra0; *(uint4*)(wA + 32 * 72) = ra1; *(uint4*)(wA + 64 * 72) = ra2; *(uint4*)(wA + 96 * 72) = ra3;
    *(uint4*)(wB) = rb0; *(uint4*)(wB + 32 * 72) = rb1; *(uint4*)(wB + 64 * 72) = rb2; *(uint4*)(wB + 96 * 72) = rb3;
  }
  __syncthreads();
  const int nk = K >> 6;
  for (int kt = 0; kt < nk; ++kt) {
    const int cur = kt & 1;
    const bool more = (kt + 1 < nk);
    if (more) {
      const u16* pa = ga + (kt + 1) * 64; const u16* pb = gb + (kt + 1) * 64;
      ra0 = *(const uint4*)(pa); ra1 = *(const uint4*)(pa + sa32); ra2 = *(const uint4*)(pa + 2 * sa32); ra3 = *(const uint4*)(pa + 3 * sa32);
      rb0 = *(const uint4*)(pb); rb1 = *(const uint4*)(pb + sb32); rb2 = *(const uint4*)(pb + 2 * sb32); rb3 = *(const uint4*)(pb + 3 * sb32);
    }
    __builtin_amdgcn_sched_barrier(0);
    const u16* cA = sA + cur * 128 * 72 + (wm * 64 + l15) * 72 + g * 8;
    const u16* cB = sB + cur * 128 * 72 + (wn * 64 + l15) * 72 + g * 8;
#pragma unroll
    for (int ks = 0; ks < 2; ++ks) {
      bf16x8 af[4], bfr[4];
#pragma unroll
      for (int i = 0; i < 4; ++i) {
        af[i] = *(const bf16x8*)(cA + i * 16 * 72 + ks * 32);
        bfr[i] = *(const bf16x8*)(cB + i * 16 * 72 + ks * 32);
      }
#pragma unroll
      for (int mt = 0; mt < 4; ++mt)
#pragma unroll
        for (int nt = 0; nt < 4; ++nt) acc[mt][nt] = mfma16(bfr[nt], af[mt], acc[mt][nt]);
    }
    __builtin_amdgcn_sched_barrier(0);
    if (more) {
      u16* wA = sA + (cur ^ 1) * 128 * 72 + lr * 72 + lc; u16* wB = sB + (cur ^ 1) * 128 * 72 + lr * 72 + lc;
      *(uint4*)(wA) = ra0; *(uint4*)(wA + 32 * 72) = ra1; *(uint4*)(wA + 64 * 72) = ra2; *(uint4*)(wA + 96 * 72) = ra3;
      *(uint4*)(wB) = rb0; *(uint4*)(wB + 32 * 72) = rb1; *(uint4*)(wB + 64 * 72) = rb2; *(uint4*)(wB + 96 * 72) = rb3;
    }
    __syncthreads();
  }
}

__device__ __forceinline__ void gemm_mainloop2(const u16* __restrict__ A, int lda, const u16* __restrict__ B, int ldb,
                                               int K, f32x4 (&acc)[4][8], u16* sm) {
  const int tid = TIDX(), lane = tid & 63, w = tid >> 6, wm = w >> 1, wn = w & 1, l15 = lane & 15, g = lane >> 4;
  constexpr int SZ = 384 * 40;
  const int lr = tid >> 2, lc = (tid & 3) * 8;
  const u16* ga = A + (size_t)lr * lda + lc;
  const u16* gb = B + (size_t)lr * ldb + lc;
  const size_t sa64 = (size_t)64 * lda, sb64 = (size_t)64 * ldb;
  uint4 ra0, ra1, rb0, rb1, rb2, rb3;
  ra0 = *(const uint4*)(ga); ra1 = *(const uint4*)(ga + sa64);
  rb0 = *(const uint4*)(gb); rb1 = *(const uint4*)(gb + sb64); rb2 = *(const uint4*)(gb + 2 * sb64); rb3 = *(const uint4*)(gb + 3 * sb64);
  {
    u16* wA = sm + lr * 40 + lc; u16* wB = sm + 128 * 40 + lr * 40 + lc;
    *(uint4*)(wA) = ra0; *(uint4*)(wA + 64 * 40) = ra1;
    *(uint4*)(wB) = rb0; *(uint4*)(wB + 64 * 40) = rb1; *(uint4*)(wB + 128 * 40) = rb2; *(uint4*)(wB + 192 * 40) = rb3;
  }
  __syncthreads();
  const int nk = K >> 5;
  for (int kt = 0; kt < nk; ++kt) {
    const int cur = kt & 1;
    const bool more = (kt + 1 < nk);
    if (more) {
      const u16* pa = ga + (kt + 1) * 32; const u16* pb = gb + (kt + 1) * 32;
      ra0 = *(const uint4*)(pa); ra1 = *(const uint4*)(pa + sa64);
      rb0 = *(const uint4*)(pb); rb1 = *(const uint4*)(pb + sb64); rb2 = *(const uint4*)(pb + 2 * sb64); rb3 = *(const uint4*)(pb + 3 * sb64);
    }
    __builtin_amdgcn_sched_barrier(0);
    const u16* cA = sm + cur * SZ + (wm * 64 + l15) * 40 + g * 8;
    const u16* cB = sm + cur * SZ + 128 * 40 + (wn * 128 + l15) * 40 + g * 8;
    bf16x8 af[4];
#pragma unroll
    for (int i = 0; i < 4; ++i) af[i] = *(const bf16x8*)(cA + i * 16 * 40);
#pragma unroll
    for (int nh = 0; nh < 2; ++nh) {
      bf16x8 bfr[4];
#pragma unroll
      for (int i = 0; i < 4; ++i) bfr[i] = *(const bf16x8*)(cB + (nh * 4 + i) * 16 * 40);
#pragma unroll
      for (int mt = 0; mt < 4; ++mt)
#pragma unroll
        for (int nt = 0; nt < 4; ++nt) acc[mt][nh * 4 + nt] = mfma16(bfr[nt], af[mt], acc[mt][nh * 4 + nt]);
    }
    __builtin_amdgcn_sched_barrier(0);
    if (more) {
      u16* wA = sm + (cur ^ 1) * SZ + lr * 40 + lc; u16* wB = sm + (cur ^ 1) * SZ + 128 * 40 + lr * 40 + lc;
      *(uint4*)(wA) = ra0; *(uint4*)(wA + 64 * 40) = ra1;
      *(uint4*)(wB) = rb0; *(uint4*)(wB + 64 * 40) = rb1; *(uint4*)(wB + 128 * 40) = rb2; *(uint4*)(wB + 192 * 40) = rb3;
    }
    __syncthreads();
  }
}

__device__ __forceinline__ void gemm_mainloop3(const u16* __restrict__ A, int lda, const u16* __restrict__ B, int ldb,
                                               int K, f32x4 (&acc)[4][8], unsigned char* smb) {
  const int tid = TIDX(), lane = tid & 63, w = tid >> 6, wm = w >> 1, wn = w & 1, l15 = lane & 15, g = lane >> 4;
  constexpr int STG = 24576;
  const int rowt = tid >> 2;
  const int cl = ((tid & 3) ^ (((tid >> 5) & 1) << 1)) * 8;
  const u16* ga = A + (size_t)rowt * lda + cl;
  const u16* gb = B + (size_t)rowt * ldb + cl;
  const size_t sa64 = (size_t)64 * lda, sb64 = (size_t)64 * ldb;
  unsigned char* wbase = smb + w * 1024;
#define GLDS16(gp, lp) __builtin_amdgcn_global_load_lds((const unsigned*)(gp), (unsigned*)(lp), 16, 0, 0)
#define ISSUE_TILE(kt_, stg_) do { \
    unsigned char* sb_ = wbase + (stg_) * STG; const u16* pa_ = ga + (kt_) * 32; const u16* pb_ = gb + (kt_) * 32; \
    GLDS16(pa_, sb_); GLDS16(pa_ + sa64, sb_ + 4096); \
    GLDS16(pb_, sb_ + 8192); GLDS16(pb_ + sb64, sb_ + 8192 + 4096); \
    GLDS16(pb_ + 2 * sb64, sb_ + 8192 + 8192); GLDS16(pb_ + 3 * sb64, sb_ + 8192 + 12288); } while (0)
  ISSUE_TILE(0, 0);
  asm volatile("s_waitcnt vmcnt(0)" ::: "memory");
  __syncthreads();
  const int csw = (g ^ (((l15 >> 3) & 1) << 1)) * 16;
  const int nk = K >> 5;
  for (int kt = 0; kt < nk; ++kt) {
    const int cur = kt & 1;
    if (kt + 1 < nk) ISSUE_TILE(kt + 1, cur ^ 1);
    __builtin_amdgcn_sched_barrier(0);
    const unsigned char* cA = smb + cur * STG + (wm * 64 + l15) * 64 + csw;
    const unsigned char* cB = smb + cur * STG + 8192 + (wn * 128 + l15) * 64 + csw;
    bf16x8 af[4];
#pragma unroll
    for (int i = 0; i < 4; ++i) af[i] = *(const bf16x8*)(cA + i * 16 * 64);
#pragma unroll
    for (int nh = 0; nh < 2; ++nh) {
      bf16x8 bfr[4];
#pragma unroll
      for (int i = 0; i < 4; ++i) bfr[i] = *(const bf16x8*)(cB + (nh * 4 + i) * 16 * 64);
#pragma unroll
      for (int nt = 0; nt < 4; ++nt)
#pragma unroll
        for (int mt = 0; mt < 4; ++mt) acc[mt][nh * 4 + nt] = mfma16(bfr[nt], af[mt], acc[mt][nh * 4 + nt]);
    }
    __builtin_amdgcn_sched_group_barrier(0x100, 6, 0);
#pragma unroll
    for (int i = 0; i < 6; ++i) {
      __builtin_amdgcn_sched_group_barrier(0x008, 4, 0);
      __builtin_amdgcn_sched_group_barrier(0x100, 1, 0);
    }
    __builtin_amdgcn_sched_group_barrier(0x008, 8, 0);
    __builtin_amdgcn_sched_barrier(0);
    asm volatile("s_waitcnt vmcnt(0)" ::: "memory");
    __syncthreads();
  }
#undef ISSUE_TILE
#undef GLDS16
}

__device__ __forceinline__ void gemm_mainloop4(const u16* __restrict__ A, int lda, const u16* __restrict__ B, int ldb,
                                               int K, f32x4 (&acc)[4][4], unsigned char* smb) {
  const int tid = TIDX(), lane = tid & 63, w = tid >> 6, wm = w >> 1, wn = w & 1, l15 = lane & 15, g = lane >> 4;
  constexpr int STG = 32768;
  const int rowt = tid >> 2;
  const int cl = ((tid & 3) ^ (((tid >> 5) & 1) << 1)) * 8;
  const u16* ga = A + (size_t)rowt * lda + cl;
  const u16* gb = B + (size_t)rowt * ldb + cl;
  const size_t sa64 = (size_t)64 * lda, sb64 = (size_t)64 * ldb;
  unsigned char* wbase = smb + w * 1024;
#define GLDS16(gp, lp) __builtin_amdgcn_global_load_lds((const unsigned*)(gp), (unsigned*)(lp), 16, 0, 0)
#define ISSUE_TILE4(kt_, stg_) do { \
    unsigned char* sb_ = wbase + (stg_) * STG; const u16* pa_ = ga + (kt_) * 64; const u16* pb_ = gb + (kt_) * 64; \
    GLDS16(pa_, sb_); GLDS16(pa_ + sa64, sb_ + 4096); \
    GLDS16(pa_ + 32, sb_ + 8192); GLDS16(pa_ + sa64 + 32, sb_ + 8192 + 4096); \
    GLDS16(pb_, sb_ + 16384); GLDS16(pb_ + sb64, sb_ + 16384 + 4096); \
    GLDS16(pb_ + 32, sb_ + 24576); GLDS16(pb_ + sb64 + 32, sb_ + 24576 + 4096); } while (0)
  __syncthreads();
  ISSUE_TILE4(0, 0);
  asm volatile("s_waitcnt vmcnt(0)" ::: "memory");
  __syncthreads();
  const int csw = (g ^ (((l15 >> 3) & 1) << 1)) * 16;
  const int nk = K >> 6;
  for (int kt = 0; kt < nk; ++kt) {
    const int cur = kt & 1;
    if (kt + 1 < nk) ISSUE_TILE4(kt + 1, cur ^ 1);
#pragma unroll
    for (int ks = 0; ks < 2; ++ks) {
      const unsigned char* cA = smb + cur * STG + ks * 8192 + (wm * 64 + l15) * 64 + csw;
      const unsigned char* cB = smb + cur * STG + 16384 + ks * 8192 + (wn * 64 + l15) * 64 + csw;
      bf16x8 af[4], bfr[4];
#pragma unroll
      for (int i = 0; i < 4; ++i) { af[i] = *(const bf16x8*)(cA + i * 1024); bfr[i] = *(const bf16x8*)(cB + i * 1024); }
#pragma unroll
      for (int nt = 0; nt < 4; ++nt)
#pragma unroll
        for (int mt = 0; mt < 4; ++mt) acc[mt][nt] = mfma16(bfr[nt], af[mt], acc[mt][nt]);
    }
    asm volatile("s_waitcnt vmcnt(0)" ::: "memory");
    __syncthreads();
  }
#undef ISSUE_TILE4
#undef GLDS16
}

__device__ __forceinline__ void acc2_to_lds(const f32x4 (&acc)[4][8], float* ct, int hf) {
  const int tid = TIDX(), lane = tid & 63, w = tid >> 6, wm = w >> 1, wn = w & 1, l15 = lane & 15, g = lane >> 4;
#pragma unroll
  for (int mt = 0; mt < 4; ++mt)
#pragma unroll
    for (int nt = 0; nt < 4; ++nt)
      *(f32x4*)(ct + (wm * 64 + mt * 16 + l15) * 132 + wn * 64 + nt * 16 + 4 * g) = acc[mt][hf * 4 + nt];
  __syncthreads();
}

__device__ __forceinline__ void tile_mn(int v, int ntn, int bn, int& m0, int& n0) {
  int grp = v / (8 * ntn), r = v % (8 * ntn);
  m0 = (grp * 8 + (r & 7)) * 128; n0 = (r >> 3) * bn;
}

#define ZERO_ACC(acc) _Pragma("unroll") for (int _a = 0; _a < 4; ++_a) _Pragma("unroll") for (int _b = 0; _b < 4; ++_b) acc[_a][_b] = f32x4{0.f, 0.f, 0.f, 0.f};

__device__ __forceinline__ void acc_to_lds(const f32x4 (&acc)[4][4], float* ct) {
  const int tid = TIDX(), lane = tid & 63, w = tid >> 6, wm = w >> 1, wn = w & 1, l15 = lane & 15, g = lane >> 4;
#pragma unroll
  for (int mt = 0; mt < 4; ++mt)
#pragma unroll
    for (int nt = 0; nt < 4; ++nt)
      *(f32x4*)(ct + (wm * 64 + mt * 16 + l15) * 132 + wn * 64 + nt * 16 + 4 * g) = acc[mt][nt];
  __syncthreads();
}

__device__ void phase_gemm_in(const Params& p, int l, unsigned char* smem) {
  const int ntn = DIN / 256;
  float* ct = (float*)smem;
  TileIter it = tile_iter((T_TOK / 128) * ntn);
  for (int v = it.v; v < it.end; v += it.step) {
    int m0, n0; tile_mn(v, ntn, 256, m0, n0);
    f32x4 acc[4][8];
#pragma unroll
    for (int a = 0; a < 4; ++a)
#pragma unroll
      for (int b = 0; b < 8; ++b) acc[a][b] = f32x4{0.f, 0.f, 0.f, 0.f};
    gemm_mainloop3(p.ACT + (size_t)m0 * DM, DM, p.WIN + (size_t)l * DIN * DM + (size_t)n0 * DM, DM, DM, acc, smem);
    const int tid = TIDX();
    const bool dv = (n0 >= C_DV && n0 < C_DG);
#pragma unroll
    for (int hf = 0; hf < 2; ++hf) {
      acc2_to_lds(acc, ct, hf);
      if (!dv) {
#pragma unroll
        for (int i = 0; i < 16; ++i) {
          int idx = tid + 256 * i, r = idx >> 5, c4 = idx & 31;
          float4 x = *(const float4*)(ct + r * 132 + 4 * c4);
          uint2 o2; o2.x = pack2(x.x, x.y); o2.y = pack2(x.z, x.w);
          *(uint2*)(p.Z + (size_t)(m0 + r) * DIN + n0 + (c4 >> 4) * 128 + hf * 64 + (c4 & 15) * 4) = o2;
        }
      } else {
#pragma unroll
        for (int i = 0; i < 16; ++i) {
          int idx = tid + 256 * i, n = idx >> 5, m4 = idx & 31;
          uint2 o2;
          o2.x = pack2(ct[(4 * m4 + 0) * 132 + n], ct[(4 * m4 + 1) * 132 + n]);
          o2.y = pack2(ct[(4 * m4 + 2) * 132 + n], ct[(4 * m4 + 3) * 132 + n]);
          const int ng = n0 + (n >> 6) * 128 + hf * 64 + (n & 63);
          *(uint2*)(p.VT + (size_t)(ng - C_DV) * T_TOK + m0 + 4 * m4) = o2;
        }
      }
      __syncthreads();
    }
  }
}

__device__ void phase_gemm_out(const Params& p, int l, unsigned char* smem, bool dry = false) {
  const int ntn = DM / 256;
  u16* H1B = p.Z;
  float* ct = (float*)smem;
  TileIter it = tile_iter((T_TOK / 128) * ntn);
  for (int v = it.v; v < it.end; v += it.step) {
    int m0, n0; tile_mn(v, ntn, 256, m0, n0);
    f32x4 acc[4][8];
#pragma unroll
    for (int a = 0; a < 4; ++a)
#pragma unroll
      for (int b = 0; b < 8; ++b) acc[a][b] = f32x4{0.f, 0.f, 0.f, 0.f};
    gemm_mainloop3(p.ACT + (size_t)m0 * DM, DM, p.WOUT + (size_t)l * DM * DM + (size_t)n0 * DM, DM, DM, acc, smem);
    const int tid = TIDX();
#pragma unroll
    for (int hf = 0; hf < 2; ++hf) {
      acc2_to_lds(acc, ct, hf);
#pragma unroll
      for (int i = 0; i < 16; ++i) {
        int idx = tid + 256 * i, r = idx >> 5, c4 = idx & 31;
        const int m = m0 + r, n = n0 + (c4 >> 4) * 128 + hf * 64 + (c4 & 15) * 4;
        float4 x = *(const float4*)(ct + r * 132 + 4 * c4);
        const float* hp = (l == 0) ? x_row(p, m) + n : p.out + (size_t)m * DM + n;
        typedef float f4v __attribute__((ext_vector_type(4)));
        const f4v hnt = __builtin_nontemporal_load((const f4v*)hp);
        float4 hv = make_float4(hnt[0], hnt[1], hnt[2], hnt[3]);
        float4 rr; rr.x = hv.x + x.x; rr.y = hv.y + x.y; rr.z = hv.z + x.z; rr.w = hv.w + x.w;
        if (!dry) {
          *(float4*)(p.out + (size_t)m * DM + n) = rr;
          uint2 o2; o2.x = pack2(rr.x, rr.y); o2.y = pack2(rr.z, rr.w);
          *(uint2*)(H1B + (size_t)m * DM + n) = o2;
        }
      }
      __syncthreads();
    }
  }
}

__device__ void phase_gemm_ple(const Params& p, int l, unsigned char* smem, bool dry = false) {
  const int ntn = DM / 128;
  const u16* H1B = p.Z;
  float* ct = (float*)smem;
  TileIter it = tile_iter((T_TOK / 128) * ntn);
  for (int v = it.v; v < it.end; v += it.step) {
    int m0, n0; tile_mn(v, ntn, 128, m0, n0);
    f32x4 acc[4][4]; ZERO_ACC(acc);
    gemm_mainloop4(H1B + (size_t)m0 * DM, DM, p.WGATE + (size_t)l * DM * DM + (size_t)n0 * DM, DM, DM, acc, smem);
    unsigned gpk[4][4][2];
#pragma unroll
    for (int mt = 0; mt < 4; ++mt)
#pragma unroll
      for (int nt = 0; nt < 4; ++nt) {
        gpk[mt][nt][0] = pack2_hw(sigmoidf_(acc[mt][nt][0]), sigmoidf_(acc[mt][nt][1]));
        gpk[mt][nt][1] = pack2_hw(sigmoidf_(acc[mt][nt][2]), sigmoidf_(acc[mt][nt][3]));
      }
    ZERO_ACC(acc);
    gemm_mainloop4(p.PB + (size_t)m0 * 256, 256, p.WPLE + (size_t)l * DM * 256 + (size_t)n0 * 256, 256, 256, acc, smem);
#pragma unroll
    for (int mt = 0; mt < 4; ++mt)
#pragma unroll
      for (int nt = 0; nt < 4; ++nt) {
        acc[mt][nt][0] *= lo_f(gpk[mt][nt][0]); acc[mt][nt][1] *= hi_f(gpk[mt][nt][0]);
        acc[mt][nt][2] *= lo_f(gpk[mt][nt][1]); acc[mt][nt][3] *= hi_f(gpk[mt][nt][1]);
      }
    acc_to_lds(acc, ct);
    const int tid = TIDX();
#pragma unroll
    for (int i = 0; i < 16; ++i) {
      int idx = tid + 256 * i, r = idx >> 5, c4 = idx & 31;
      float4 x = *(const float4*)(ct + r * 132 + 4 * c4);
      float* hp = p.out + (size_t)(m0 + r) * DM + n0 + 4 * c4;
      typedef float f4v __attribute__((ext_vector_type(4)));
      const f4v hnt = __builtin_nontemporal_load((const f4v*)hp);
      float4 hv = make_float4(hnt[0], hnt[1], hnt[2], hnt[3]);
      hv.x += x.x; hv.y += x.y; hv.z += x.z; hv.w += x.w;
      if (!dry) *(float4*)hp = hv;
    }
    __syncthreads();
  }
}

__device__ void phase_krope(const Params& p, int l) {
  for (int i = BIDX() * 256 + TIDX(); i < T_TOK * 8; i += gridDim.x * 256) {
    int t = i >> 3, hh = i & 7;
    u16* ptr = p.Z + (size_t)t * DIN + C_DK + hh * 32;
    uint4 raw = *(const uint4*)ptr;
    uint4 r1 = *(const uint4*)(ptr + 8), r2 = *(const uint4*)(ptr + 16), r3 = *(const uint4*)(ptr + 24);
    float x[8], y[8]; unpack8(raw, x);
    const float* rt = p.ROPE + (size_t)tok_pos(t) * 8;
#pragma unroll
    for (int k = 0; k < 4; ++k) {
      float c = rt[2 * k], s = rt[2 * k + 1];
      y[k] = x[k] * c - x[k + 4] * s;
      y[k + 4] = x[k + 4] * c + x[k] * s;
    }
    *(uint4*)ptr = pack8(y);
    float k2 = 0.f;
#pragma unroll
    for (int k = 0; k < 8; ++k) k2 += x[k] * x[k];
    float z[8];
    unpack8(r1, z);
#pragma unroll
    for (int k = 0; k < 8; ++k) k2 += z[k] * z[k];
    unpack8(r2, z);
#pragma unroll
    for (int k = 0; k < 8; ++k) k2 += z[k] * z[k];
    unpack8(r3, z);
#pragma unroll
    for (int k = 0; k < 8; ++k) k2 += z[k] * z[k];
    k2 = fmaxf(k2, __shfl_xor(k2, 8));
    k2 = fmaxf(k2, __shfl_xor(k2, 16));
    k2 = fmaxf(k2, __shfl_xor(k2, 32));
    if ((TIDX() & 63) < 8) {
      const int seq = t < T_PROMPT ? (t >> 12) : 16 + ((t - T_PROMPT) >> 11);
      atomicMax(p.KMAX + (l * 32 + seq) * 8 + hh, __float_as_uint(k2));
    }
  }
}

template <bool FINAL>
__device__ void phase_lru(const Params& p, int l, unsigned char* smem) {
  u16* xs = (u16*)smem;
  float* u32 = (float*)(smem + 8704);
  u16* ub = (u16*)(smem + 25088);
  float* sa = (float*)(smem + 34304);
  float* sb = (float*)(smem + 50688);
  float* part = (float*)(smem + 67072);
  const int tid = TIDX(), lane = tid & 63, w = tid >> 6, l15 = lane & 15, g = lane >> 4;
  const int e_ = tid & 63, qd = tid >> 6;
  const int NIT = NCHUNK * 8;
  const int step = gridDim.x;
  int it = BIDX();
  uint4 x0 = make_uint4(0, 0, 0, 0), x1 = x0, x2 = x0;
  auto load_x = [&](int item, uint4& a0, uint4& a1, uint4& a2) {
    const int ci = item >> 3, nb = item & 7;
    const int tb = ci * 64, pos0 = tok_pos(tb), S = tok_len(tb);
    const u16* zb = p.Z + (long)(tb - 2) * DIN + C_LX + nb * 64;
    { int idx = tid, r = idx >> 3, ch = idx & 7, pp = pos0 - 2 + r;
      a0 = (pp >= 0 && pp < S) ? *(const uint4*)(zb + (long)r * DIN + ch * 8) : make_uint4(0, 0, 0, 0); }
    { int idx = tid + 256, r = idx >> 3, ch = idx & 7, pp = pos0 - 2 + r;
      a1 = (pp >= 0 && pp < S) ? *(const uint4*)(zb + (long)r * DIN + ch * 8) : make_uint4(0, 0, 0, 0); }
    { int idx = tid + 512, r = idx >> 3, ch = idx & 7, pp = pos0 - 2 + r;
      a2 = (idx < 67 * 8 && pp >= 0 && pp < S) ? *(const uint4*)(zb + (long)r * DIN + ch * 8) : make_uint4(0, 0, 0, 0); }
  };
  if (it < NIT) load_x(it, x0, x1, x2);
  for (; it < NIT; it += step) {
    const int ci = it >> 3, nb = it & 7;
    const int tb = ci * 64;
    __syncthreads();
    *(uint4*)(xs + (tid >> 3) * 64 + (tid & 7) * 8) = x0;
    *(uint4*)(xs + ((tid + 256) >> 3) * 64 + (tid & 7) * 8) = x1;
    if (tid + 512 < 67 * 8) *(uint4*)(xs + ((tid + 512) >> 3) * 64 + (tid & 7) * 8) = x2;
    uint4 gz0 = make_uint4(0, 0, 0, 0), gz1 = gz0;
    float cin0 = 0.f, cin1 = 0.f;
    if (FINAL) {
      const u16* gb = p.Z + (size_t)tb * DIN + C_LG + nb * 64 + (tid & 7) * 8;
      typedef unsigned u4v __attribute__((ext_vector_type(4)));
      const u4v g0_ = __builtin_nontemporal_load((const u4v*)(gb + (size_t)(tid >> 3) * DIN));
      const u4v g1_ = __builtin_nontemporal_load((const u4v*)(gb + (size_t)((tid >> 3) + 32) * DIN));
      gz0 = make_uint4(g0_[0], g0_[1], g0_[2], g0_[3]);
      gz1 = make_uint4(g1_[0], g1_[1], g1_[2], g1_[3]);
      cin0 = p.CB[((size_t)ci * 2 + 0) * 512 + nb * 64 + e_];
      cin1 = p.CB[((size_t)ci * 2 + 1) * 512 + nb * 64 + e_];
    }
    __syncthreads();
    if (it + step < NIT) load_x(it + step, x0, x1, x2);
    {
      const int ch = nb * 64 + e_;
      const float cw0 = p.conv_w[(l * 4 + 0) * 512 + ch], cw1 = p.conv_w[(l * 4 + 1) * 512 + ch],
                  cw2 = p.conv_w[(l * 4 + 2) * 512 + ch], cw3 = p.conv_w[(l * 4 + 3) * 512 + ch];
      const float cb = p.conv_b[l * 512 + ch];
      float xv[19];
#pragma unroll
      for (int k = 0; k < 19; ++k) xv[k] = bf2f(xs[(qd * 16 + k) * 64 + e_]);
#pragma unroll
      for (int tt = 0; tt < 16; ++tt) {
        const int t = qd * 16 + tt;
        const float u = cb + xv[tt] * cw0 + xv[tt + 1] * cw1 + xv[tt + 2] * cw2 + xv[tt + 3] * cw3;
        u32[t * 64 + e_] = u;
        ub[t * 72 + e_] = (u16)f2bf(u);
      }
    }
    __syncthreads();
    if (FINAL) {
      *(uint4*)(xs + (tid >> 3) * 64 + (tid & 7) * 8) = gz0;
      *(uint4*)(xs + ((tid >> 3) + 32) * 64 + (tid & 7) * 8) = gz1;
    }
    float hsum[16];
#pragma unroll
    for (int tt = 0; tt < 16; ++tt) hsum[tt] = 0.f;
#pragma unroll
    for (int d = 0; d < 2; ++d) {
      {
        bf16x8 uf[2];
        uf[0] = *(const bf16x8*)(ub + (16 * w + l15) * 72 + g * 8);
        uf[1] = *(const bf16x8*)(ub + (16 * w + l15) * 72 + 32 + g * 8);
        const int t = 16 * w + l15;
#pragma unroll
        for (int et = 0; et < 4; ++et) {
          f32x4 ar = {0.f, 0.f, 0.f, 0.f}, ai = {0.f, 0.f, 0.f, 0.f};
          const u16* wr = p.WLRU + ((((size_t)(l * 2 + d) * 2 + 0) * 8 + nb) * 64 + et * 16 + l15) * 64 + g * 8;
          const u16* wi = p.WLRU + ((((size_t)(l * 2 + d) * 2 + 1) * 8 + nb) * 64 + et * 16 + l15) * 64 + g * 8;
#pragma unroll
          for (int ks = 0; ks < 2; ++ks) {
            ar = mfma16(*(const bf16x8*)(wr + ks * 32), uf[ks], ar);
            ai = mfma16(*(const bf16x8*)(wi + ks * 32), uf[ks], ai);
          }
          const int e0 = et * 16 + 4 * g, ch0 = nb * 64 + e0;
          const float4 ba4 = *(const float4*)(p.ba + (l * 2 + d) * 512 + ch0);
          const float4 bx4 = *(const float4*)(p.bx + (l * 2 + d) * 512 + ch0);
          const float4 sp4 = *(const float4*)(p.SP8 + (l * 2 + d) * 512 + ch0);
          const float4 uu = *(const float4*)(u32 + t * 64 + e0);
          const float* bap = (const float*)&ba4; const float* bxp = (const float*)&bx4;
          const float* spp = (const float*)&sp4; const float* uup = (const float*)&uu;
          f32x4 av, bv;
#pragma unroll
          for (int j = 0; j < 4; ++j) {
            float r = sigmoidf_(ar[j] + bap[j]);
            float ig = sigmoidf_(ai[j] + bxp[j]);
            float la = spp[j] * r;
            float av_ = __expf(la);
            float t2 = 2.0f * la;
            float ser = -t2 * (1.f + t2 * 0.5f * (1.f + t2 * (1.f / 3.f) * (1.f + t2 * 0.25f * (1.f + t2 * 0.2f))));
            float om = (t2 > -0.25f) ? ser : (1.0f - av_ * av_);
            av[j] = av_;
            bv[j] = __builtin_amdgcn_sqrtf(om) * ig * uup[j];
          }
          *(f32x4*)(sa + t * 64 + e0) = av;
          *(f32x4*)(sb + t * 64 + e0) = bv;
        }
      }
      __syncthreads();
      {
        float A = 1.f, B = 0.f;
        if (d == 0) {
#pragma unroll
          for (int tt = 0; tt < 16; ++tt) { int t = qd * 16 + tt; float a = sa[t * 64 + e_], b = sb[t * 64 + e_]; B = a * B + b; A *= a; }
        } else {
#pragma unroll
          for (int tt = 15; tt >= 0; --tt) { int t = qd * 16 + tt; float a = sa[t * 64 + e_], b = sb[t * 64 + e_]; B = a * B + b; A *= a; }
        }
        part[(0 * 4 + qd) * 64 + e_] = A;
        part[(1 * 4 + qd) * 64 + e_] = B;
      }
      __syncthreads();
      if (!FINAL) {
        if (qd == 0) {
          float A = 1.f, B = 0.f;
          if (d == 0) {
#pragma unroll
            for (int q = 0; q < 4; ++q) { float aq = part[q * 64 + e_], bq = part[(4 + q) * 64 + e_]; B = aq * B + bq; A *= aq; }
          } else {
#pragma unroll
            for (int q = 3; q >= 0; --q) { float aq = part[q * 64 + e_], bq = part[(4 + q) * 64 + e_]; B = aq * B + bq; A *= aq; }
          }
          const size_t cidx = ((size_t)ci * 2 + d) * 512 + nb * 64 + e_;
          p.CA[cidx] = A; p.CB[cidx] = B;
        }
      } else {
        float h = d ? cin1 : cin0;
        if (d == 0) {
#pragma unroll
          for (int q = 0; q < 4; ++q) if (q < qd) h = part[q * 64 + e_] * h + part[(4 + q) * 64 + e_];
#pragma unroll
          for (int tt = 0; tt < 16; ++tt) { int t = qd * 16 + tt; h = sa[t * 64 + e_] * h + sb[t * 64 + e_]; hsum[tt] += h; }
        } else {
#pragma unroll
          for (int q = 3; q >= 0; --q) if (q > qd) h = part[q * 64 + e_] * h + part[(4 + q) * 64 + e_];
#pragma unroll
          for (int tt = 15; tt >= 0; --tt) { int t = qd * 16 + tt; h = sa[t * 64 + e_] * h + sb[t * 64 + e_]; hsum[tt] += h; }
        }
      }
      __syncthreads();
    }
    if (FINAL) {
#pragma unroll
      for (int tt = 0; tt < 16; ++tt) {
        const int t = qd * 16 + tt;
        const float gzv = bf2f(xs[t * 64 + e_]);
        ub[t * 72 + e_] = (u16)f2bf(hsum[tt] * siluf_(gzv));
      }
      __syncthreads();
      u16* ob = p.ACT + (size_t)tb * DM + 256 + nb * 64 + (tid & 7) * 8;
      *(uint4*)(ob + (size_t)(tid >> 3) * DM) = *(const uint4*)(ub + (tid >> 3) * 72 + (tid & 7) * 8);
      *(uint4*)(ob + (size_t)((tid >> 3) + 32) * DM) = *(const uint4*)(ub + ((tid >> 3) + 32) * 72 + (tid & 7) * 8);
    }
  }
  __syncthreads();
}

__device__ void lru_scan_item(const Params& p, int item) {
  const int i = item * 256 + TIDX();
  const int seq = i >> 10, d = (i >> 9) & 1, ch = i & 511;
  int base, len; seq_info(seq, base, len);
  const int c0 = base >> 6, nc = len >> 6;
  float h = 0.f;
  for (int n0 = 0; n0 < nc; n0 += 16) {
    float a[16], b[16];
#pragma unroll
    for (int k = 0; k < 16; ++k) {
      const int n = d ? (nc - 1 - (n0 + k)) : (n0 + k);
      const size_t ix = ((size_t)(c0 + n) * 2 + d) * 512 + ch;
      a[k] = p.CA[ix]; b[k] = p.CB[ix];
    }
#pragma unroll
    for (int k = 0; k < 16; ++k) {
      const int n = d ? (nc - 1 - (n0 + k)) : (n0 + k);
      const size_t ix = ((size_t)(c0 + n) * 2 + d) * 512 + ch;
      p.CB[ix] = h; h = a[k] * h + b[k];
    }
  }
}

__device__ void hgrn_item(const Params& p, int l, int item, unsigned char* smem, bool dry = false) {
  float* LF = (float*)smem;
  u16* KKB = (u16*)(smem + 16384);
  u16* QH = (u16*)(smem + 25600);
  u16* QT = (u16*)(smem + 34816);
  u16* KHT = (u16*)(smem + 44032);
  u16* VTt = (u16*)(smem + 53248);
  u16* ST = (u16*)(smem + 62464);
  float* part = (float*)(smem + 71680);
  const int tid = TIDX(), lane = tid & 63, w = tid >> 6, l15 = lane & 15, g = lane >> 4;
  const int seq = item >> 3, h = (item >> 1) & 3, d = item & 1;
  int base, len; seq_info(seq, base, len);
  const int nc = len >> 6;
  const int r0 = tid >> 3, kc = tid & 7;
  const int cfslot = d ? C_HFB : C_HFF;
  float lbv[8];
#pragma unroll
  for (int e = 0; e < 8; ++e) {
    if (l == 0) lbv[e] = 0.f;
    else {
      float a1 = p.hg_lb[(1 * 2 + d) * 256 + 64 * h + 8 * kc + e], a0 = p.hg_lb[(0 * 2 + d) * 256 + 64 * h + 8 * kc + e];
      lbv[e] = sigmoidf_(a1 - a0);
    }
  }
  __syncthreads();
  for (int i = tid; i < 64 * 72 / 2; i += 256) ((unsigned*)ST)[i] = 0u;
  f32x4 Sacc[4];
#pragma unroll
  for (int vt = 0; vt < 4; ++vt) Sacc[vt] = f32x4{0.f, 0.f, 0.f, 0.f};
  uint4 rq[2], rf[2], rv[2];
#define HG_TOK(n, i) (d ? (base + len - 1 - ((n) * 64 + (i))) : (base + (n) * 64 + (i)))
#pragma unroll
  for (int s = 0; s < 2; ++s) {
    const u16* zr = p.Z + (size_t)HG_TOK(0, r0 + 32 * s) * DIN + 64 * h + 8 * kc;
    rq[s] = *(const uint4*)(zr + C_HQ); { typedef unsigned u4v __attribute__((ext_vector_type(4))); const u4v t_ = __builtin_nontemporal_load((const u4v*)(zr + cfslot)); rf[s] = make_uint4(t_[0], t_[1], t_[2], t_[3]); } rv[s] = *(const uint4*)(zr + C_HI);
  }
  for (int n = 0; n < nc; ++n) {
    float qs[2][8], kk[2][8];
    uint4 vraw[2];
#pragma unroll
    for (int s = 0; s < 2; ++s) {
      const int i = r0 + 32 * s;
      float zf[8], zq[8], lf[8];
      unpack8(rf[s], zf); unpack8(rq[s], zq);
      vraw[s] = rv[s];
#pragma unroll
      for (int e = 0; e < 8; ++e) {
        float sg = sigmoidf_(zf[e]);
        float f = lbv[e] + (1.f - lbv[e]) * sg;
        lf[e] = __logf(f);
        kk[s][e] = (1.f - lbv[e]) * (1.f - sg);
        qs[s][e] = siluf_(zq[e]);
      }
      *(float4*)(LF + i * 64 + 8 * kc) = make_float4(lf[0], lf[1], lf[2], lf[3]);
      *(float4*)(LF + i * 64 + 8 * kc + 4) = make_float4(lf[4], lf[5], lf[6], lf[7]);
      *(uint4*)(KKB + i * 72 + 8 * kc) = pack8(kk[s]);
    }
    if (n + 1 < nc) {
#pragma unroll
      for (int s = 0; s < 2; ++s) {
        const u16* zr = p.Z + (size_t)HG_TOK(n + 1, r0 + 32 * s) * DIN + 64 * h + 8 * kc;
        rq[s] = *(const uint4*)(zr + C_HQ); { typedef unsigned u4v __attribute__((ext_vector_type(4))); const u4v t_ = __builtin_nontemporal_load((const u4v*)(zr + cfslot)); rf[s] = make_uint4(t_[0], t_[1], t_[2], t_[3]); } rv[s] = *(const uint4*)(zr + C_HI);
      }
    }
    __syncthreads();
    {
      const int k = tid & 63, qd = tid >> 6;
      float s = 0.f;
#pragma unroll
      for (int tt = 0; tt < 16; ++tt) { int i = qd * 16 + tt; s += LF[i * 64 + k]; LF[i * 64 + k] = s; }
      part[qd * 64 + k] = s;
    }
    __syncthreads();
    {
      const int k = tid & 63, qd = tid >> 6;
      float off = 0.f;
#pragma unroll
      for (int q = 0; q < 3; ++q) if (q < qd) off += part[q * 64 + k];
      if (qd > 0) {
#pragma unroll
        for (int tt = 0; tt < 16; ++tt) { int i = qd * 16 + tt; LF[i * 64 + k] += off; }
      }
    }
    __syncthreads();
#pragma unroll
    for (int s = 0; s < 2; ++s) {
      const int i = r0 + 32 * s, I = i >> 4;
      float c8[8], cl8[8], cp8[8], qh[8], qt[8], vv[8];
      *(float4*)(c8) = *(const float4*)(LF + i * 64 + 8 * kc); *(float4*)(c8 + 4) = *(const float4*)(LF + i * 64 + 8 * kc + 4);
      *(float4*)(cl8) = *(const float4*)(LF + 63 * 64 + 8 * kc); *(float4*)(cl8 + 4) = *(const float4*)(LF + 63 * 64 + 8 * kc + 4);
      if (I > 0) {
        *(float4*)(cp8) = *(const float4*)(LF + (16 * I - 1) * 64 + 8 * kc); *(float4*)(cp8 + 4) = *(const float4*)(LF + (16 * I - 1) * 64 + 8 * kc + 4);
      } else {
#pragma unroll
        for (int e = 0; e < 8; ++e) cp8[e] = 0.f;
      }
      unpack8(vraw[s], vv);
#pragma unroll
      for (int e = 0; e < 8; ++e) {
        qt[e] = qs[s][e] * __expf(c8[e] - cp8[e]);
        qh[e] = qs[s][e] * __expf(c8[e]);
        KHT[(8 * kc + e) * 72 + i] = (u16)f2bf(kk[s][e] * __expf(cl8[e] - c8[e]));
        VTt[(8 * kc + e) * 72 + i] = (u16)f2bf(vv[e]);
      }
      *(uint4*)(QH + i * 72 + 8 * kc) = pack8(qh);
      *(uint4*)(QT + i * 72 + 8 * kc) = pack8(qt);
    }
    __syncthreads();
    float clw[4];
    {
      const int I = w;
      float cpI[2][8];
#pragma unroll
      for (int ks = 0; ks < 2; ++ks)
#pragma unroll
        for (int e = 0; e < 8; ++e) cpI[ks][e] = (I > 0) ? LF[(16 * I - 1) * 64 + 32 * ks + 8 * g + e] : 0.f;
#pragma unroll
      for (int j = 0; j < 4; ++j) clw[j] = LF[63 * 64 + 16 * w + 4 * g + j];
      f32x4 acc[4];
#pragma unroll
      for (int vt = 0; vt < 4; ++vt) acc[vt] = f32x4{0.f, 0.f, 0.f, 0.f};
      bf16x8 qtf[2];
#pragma unroll
      for (int ks = 0; ks < 2; ++ks) {
        bf16x8 qhf = *(const bf16x8*)(QH + (16 * I + l15) * 72 + 32 * ks + 8 * g);
        qtf[ks] = *(const bf16x8*)(QT + (16 * I + l15) * 72 + 32 * ks + 8 * g);
#pragma unroll
        for (int vt = 0; vt < 4; ++vt) {
          bf16x8 stf = *(const bf16x8*)(ST + (16 * vt + l15) * 72 + 32 * ks + 8 * g);
          acc[vt] = mfma16(stf, qhf, acc[vt]);
        }
      }
      unsigned pk[2][4];
#pragma unroll
      for (int a = 0; a < 2; ++a)
#pragma unroll
        for (int b = 0; b < 4; ++b) pk[a][b] = 0u;
#pragma unroll
      for (int J = 0; J < 4; ++J) {
        if (J <= I) {
          f32x4 sT = {0.f, 0.f, 0.f, 0.f};
#pragma unroll
          for (int ks = 0; ks < 2; ++ks) {
            uint4 kraw = *(const uint4*)(KKB + (16 * J + l15) * 72 + 32 * ks + 8 * g);
            float kx[8], cj[8];
            unpack8(kraw, kx);
            *(float4*)(cj) = *(const float4*)(LF + (16 * J + l15) * 64 + 32 * ks + 8 * g);
            *(float4*)(cj + 4) = *(const float4*)(LF + (16 * J + l15) * 64 + 32 * ks + 8 * g + 4);
#pragma unroll
            for (int e = 0; e < 8; ++e) kx[e] *= __expf(cpI[ks][e] - cj[e]);
            uint4 kf = pack8(kx);
            sT = mfma16(as_bf8(kf), qtf[ks], sT);
          }
          if (J == I) {
#pragma unroll
            for (int j = 0; j < 4; ++j) if (4 * g + j > l15) sT[j] = 0.f;
          }
          pk[J >> 1][(J & 1) * 2 + 0] = pack2(sT[0], sT[1]);
          pk[J >> 1][(J & 1) * 2 + 1] = pack2(sT[2], sT[3]);
        }
      }
#pragma unroll
      for (int kp = 0; kp < 2; ++kp) {
        if (kp <= (I >> 1)) {
          uint4 pv = make_uint4(pk[kp][0], pk[kp][1], pk[kp][2], pk[kp][3]);
#pragma unroll
          for (int vt = 0; vt < 4; ++vt) {
            uint2 a = *(const uint2*)(VTt + (16 * vt + l15) * 72 + 32 * kp + 4 * g);
            uint2 b = *(const uint2*)(VTt + (16 * vt + l15) * 72 + 32 * kp + 16 + 4 * g);
            uint4 vf = make_uint4(a.x, a.y, b.x, b.y);
            acc[vt] = mfma16(as_bf8(vf), as_bf8(pv), acc[vt]);
          }
        }
      }
      u16* orow = dry ? (p.ACT + (size_t)HG_TOK(n, 16 * I + l15) * DM + 64 * h) : (p.Z + (size_t)HG_TOK(n, 16 * I + l15) * DIN + cfslot + 64 * h);
#pragma unroll
      for (int vt = 0; vt < 4; ++vt) {
        uint2 o2; o2.x = pack2(acc[vt][0], acc[vt][1]); o2.y = pack2(acc[vt][2], acc[vt][3]);
        *(uint2*)(orow + 16 * vt + 4 * g) = o2;
      }
    }
    __syncthreads();
    {
      float dec[4];
#pragma unroll
      for (int j = 0; j < 4; ++j) dec[j] = __expf(clw[j]);
#pragma unroll
      for (int vt = 0; vt < 4; ++vt)
#pragma unroll
        for (int j = 0; j < 4; ++j) Sacc[vt][j] *= dec[j];
#pragma unroll
      for (int ks = 0; ks < 2; ++ks) {
        bf16x8 khf = *(const bf16x8*)(KHT + (16 * w + l15) * 72 + 32 * ks + 8 * g);
#pragma unroll
        for (int vt = 0; vt < 4; ++vt) {
          bf16x8 vtf = *(const bf16x8*)(VTt + (16 * vt + l15) * 72 + 32 * ks + 8 * g);
          Sacc[vt] = mfma16(khf, vtf, Sacc[vt]);
        }
      }
#pragma unroll
      for (int vt = 0; vt < 4; ++vt) {
        uint2 o2; o2.x = pack2(Sacc[vt][0], Sacc[vt][1]); o2.y = pack2(Sacc[vt][2], Sacc[vt][3]);
        *(uint2*)(ST + (16 * vt + l15) * 72 + 16 * w + 4 * g) = o2;
      }
    }
  }
#undef HG_TOK
  __syncthreads();
}

__device__ void phase_hgrn_combine(const Params& p, int l) {
  const int lane = TIDX() & 63;
  const int gw = BIDX() * 4 + (TIDX() >> 6), nw = gridDim.x * 4;
  const int hd = lane >> 4, sub = lane & 15;
  const float4 gn = *(const float4*)(p.hg_norm + l * 64 + 4 * sub);
  for (int t = gw; t < T_TOK; t += nw) {
    const u16* zr = p.Z + (size_t)t * DIN + 64 * hd + 4 * sub;
    typedef unsigned u2v __attribute__((ext_vector_type(2)));
    const u2v a_ = __builtin_nontemporal_load((const u2v*)(zr + C_HFF)), b_ = __builtin_nontemporal_load((const u2v*)(zr + C_HFB)),
              g_ = __builtin_nontemporal_load((const u2v*)(zr + C_HG));
    uint2 a = make_uint2(a_[0], a_[1]), b = make_uint2(b_[0], b_[1]), gz = make_uint2(g_[0], g_[1]);
    float o0 = lo_f(a.x) + lo_f(b.x), o1 = hi_f(a.x) + hi_f(b.x), o2 = lo_f(a.y) + lo_f(b.y), o3 = hi_f(a.y) + hi_f(b.y);
    float ss = o0 * o0 + o1 * o1 + o2 * o2 + o3 * o3;
#pragma unroll
    for (int o = 8; o >= 1; o >>= 1) ss += __shfl_xor(ss, o);
    float rs = rsqrtf(ss * (1.0f / 64.0f) + RMS_EPS);
    uint2 r;
    r.x = pack2_hw(o0 * rs * gn.x * siluf_(lo_f(gz.x)), o1 * rs * gn.y * siluf_(hi_f(gz.x)));
    r.y = pack2_hw(o2 * rs * gn.z * siluf_(lo_f(gz.y)), o3 * rs * gn.w * siluf_(hi_f(gz.y)));
    *(uint2*)(p.ACT + (size_t)t * DM + 64 * hd + 4 * sub) = r;
  }
}

__device__ void attn_item(const Params& p, int l, int item, unsigned char* smem) {
  const int tid = TIDX(), lane = tid & 63, w = tid >> 6, l15 = lane & 15, g = lane >> 4;
  int seq, h, qb;
  if (item < 2048) { seq = item >> 7; h = (item >> 5) & 3; qb = item & 31; }
  else { int id = item - 2048; seq = 16 + (id >> 6); h = (id >> 4) & 3; qb = id & 15; }
  int tb, len; seq_info(seq, tb, len);
  const int q0 = qb * 128 + 32 * w;
  const float SC = 0.17677669529663687f * 1.4426950408889634f;
  bf16x8 Qf[2][2];
  float cref[2][2];
#pragma unroll
  for (int hh = 0; hh < 2; ++hh)
#pragma unroll
    for (int qt = 0; qt < 2; ++qt) {
      const int qpos = q0 + 16 * qt + l15;
      uint4 raw = *(const uint4*)(p.Z + (size_t)(tb + qpos) * DIN + C_DQ + (2 * h + hh) * 32 + 8 * g);
      float x[8], y[8]; unpack8(raw, x);
      if (g == 0) {
        const float* rt = p.ROPE + (size_t)qpos * 8;
#pragma unroll
        for (int k = 0; k < 4; ++k) {
          float c = rt[2 * k], s = rt[2 * k + 1];
          y[k] = x[k] * c - x[k + 4] * s;
          y[k + 4] = x[k + 4] * c + x[k] * s;
        }
      } else {
#pragma unroll
        for (int k = 0; k < 8; ++k) y[k] = x[k];
      }
      float q2 = 0.f;
#pragma unroll
      for (int k = 0; k < 8; ++k) { y[k] *= SC; q2 += y[k] * y[k]; }
      q2 += __shfl_xor(q2, 16); q2 += __shfl_xor(q2, 32);
      cref[hh][qt] = sqrtf(q2 * __uint_as_float(p.KMAX[(l * 32 + seq) * 8 + 2 * h + hh])) * 1.02f;
      Qf[hh][qt] = as_bf8(pack8(y));
    }
  const bool fixedref = (__builtin_amdgcn_ballot_w64(fmaxf(fmaxf(cref[0][0], cref[0][1]), fmaxf(cref[1][0], cref[1][1])) > 40.0f) == 0);
  f32x4 O[2][4][2];
  float mrun[2][2];
  f32x4 Ol[2][2];
  const bf16x8 ones8 = as_bf8(make_uint4(0x3F803F80u, 0x3F803F80u, 0x3F803F80u, 0x3F803F80u));
#pragma unroll
  for (int hh = 0; hh < 2; ++hh)
#pragma unroll
    for (int qt = 0; qt < 2; ++qt) {
      mrun[hh][qt] = fixedref ? cref[hh][qt] : 0.f; Ol[hh][qt] = f32x4{0.f, 0.f, 0.f, 0.f};
#pragma unroll
      for (int dt = 0; dt < 4; ++dt) O[hh][dt][qt] = f32x4{0.f, 0.f, 0.f, 0.f};
    }
  const int nkt = len >> 6;
  const int srow = tid >> 3, sch = (tid & 7) * 8;
  const u16* gk = p.Z + (size_t)(tb + srow) * DIN + C_DK + 64 * h + sch;
  const u16* gv = p.VT + (size_t)(64 * h + srow) * T_TOK + tb + sch;
  u16* sbase = (u16*)smem;
  uint4 rk0, rk1, rv0, rv1;
  __syncthreads();
  rk0 = *(const uint4*)(gk);
  rk1 = *(const uint4*)(gk + (size_t)32 * DIN);
  rv0 = *(const uint4*)(gv);
  rv1 = *(const uint4*)(gv + (size_t)32 * T_TOK);
  *(uint4*)(sbase + srow * 72 + sch) = rk0;
  *(uint4*)(sbase + (srow + 32) * 72 + sch) = rk1;
  *(uint4*)(sbase + 64 * 72 + srow * 72 + sch) = rv0;
  *(uint4*)(sbase + 64 * 72 + (srow + 32) * 72 + sch) = rv1;
  __syncthreads();
  for (int kt = 0; kt < nkt; ++kt) {
    const int cur = kt & 1;
    const bool more = (kt + 1 < nkt);
    if (more) {
      rk0 = *(const uint4*)(gk + (size_t)((kt + 1) * 64) * DIN);
      rk1 = *(const uint4*)(gk + (size_t)((kt + 1) * 64 + 32) * DIN);
      rv0 = *(const uint4*)(gv + (kt + 1) * 64);
      rv1 = *(const uint4*)(gv + (size_t)32 * T_TOK + (kt + 1) * 64);
    }
    __builtin_amdgcn_sched_barrier(0);
    const u16* KS = sbase + cur * (2 * 64 * 72);
    const u16* VS = KS + 64 * 72;
#pragma unroll
    for (int hh = 0; hh < 2; ++hh) {
      bf16x8 Pf[2][2];
      f32x4 st[4][2];
      {
        f32x4 ci0, ci1;
        ci0[0] = ci0[1] = ci0[2] = ci0[3] = -mrun[hh][0];
        ci1[0] = ci1[1] = ci1[2] = ci1[3] = -mrun[hh][1];
#pragma unroll
        for (int k4 = 0; k4 < 4; ++k4) {
          bf16x8 kf = *(const bf16x8*)(KS + (16 * k4 + l15) * 72 + 32 * hh + 8 * g);
          st[k4][0] = mfma16(kf, Qf[hh][0], ci0);
          st[k4][1] = mfma16(kf, Qf[hh][1], ci1);
        }
      }
      __builtin_amdgcn_sched_barrier(0);
      if (!fixedref) {
      float mx[2];
#pragma unroll
      for (int qt = 0; qt < 2; ++qt) {
        float m_ = st[0][qt][0];
#pragma unroll
        for (int k4 = 0; k4 < 4; ++k4)
#pragma unroll
          for (int j = 0; j < 4; ++j) m_ = fmaxf(m_, st[k4][qt][j]);
        m_ = fmaxf(m_, __shfl_xor(m_, 16));
        m_ = fmaxf(m_, __shfl_xor(m_, 32));
        mx[qt] = m_;
      }
      const bool upd = (kt == 0) || (__builtin_amdgcn_ballot_w64(fmaxf(mx[0], mx[1]) > 8.0f) != 0);
      if (upd) {
#pragma unroll
        for (int qt = 0; qt < 2; ++qt) {
          const float delta = (kt == 0 || mx[qt] > 8.0f) ? mx[qt] : 0.f;
          mrun[hh][qt] += delta;
          const float alpha = __builtin_amdgcn_exp2f(-delta);
#pragma unroll
          for (int j = 0; j < 4; ++j) Ol[hh][qt][j] *= alpha;
#pragma unroll
          for (int dt = 0; dt < 4; ++dt)
#pragma unroll
            for (int j = 0; j < 4; ++j) O[hh][dt][qt][j] *= alpha;
#pragma unroll
          for (int k4 = 0; k4 < 4; ++k4)
#pragma unroll
            for (int j = 0; j < 4; ++j) st[k4][qt][j] -= delta;
        }
      }
      }
#pragma unroll
      for (int qt = 0; qt < 2; ++qt) {
#pragma unroll
        for (int k4 = 0; k4 < 4; ++k4)
#pragma unroll
          for (int j = 0; j < 4; ++j) st[k4][qt][j] = __builtin_amdgcn_exp2f(st[k4][qt][j]);
#pragma unroll
        for (int ks = 0; ks < 2; ++ks) {
          uint4 pk;
          pk.x = pack2_hw(st[2 * ks][qt][0], st[2 * ks][qt][1]); pk.y = pack2_hw(st[2 * ks][qt][2], st[2 * ks][qt][3]);
          pk.z = pack2_hw(st[2 * ks + 1][qt][0], st[2 * ks + 1][qt][1]); pk.w = pack2_hw(st[2 * ks + 1][qt][2], st[2 * ks + 1][qt][3]);
          Pf[qt][ks] = as_bf8(pk);
          Ol[hh][qt] = mfma16(ones8, Pf[qt][ks], Ol[hh][qt]);
        }
        __builtin_amdgcn_sched_barrier(0);
      }
#pragma unroll
    for (int dt = 0; dt < 4; ++dt) {
      bf16x8 Vf[2];
#pragma unroll
      for (int ks = 0; ks < 2; ++ks) {
        uint2 a = *(const uint2*)(VS + (16 * dt + l15) * 72 + 32 * ks + 4 * g);
        uint2 b = *(const uint2*)(VS + (16 * dt + l15) * 72 + 32 * ks + 16 + 4 * g);
        Vf[ks] = as_bf8(make_uint4(a.x, a.y, b.x, b.y));
      }
#pragma unroll
        for (int qt = 0; qt < 2; ++qt)
#pragma unroll
          for (int ks = 0; ks < 2; ++ks) O[hh][dt][qt] = mfma16(Vf[ks], Pf[qt][ks], O[hh][dt][qt]);
    }
    }
    __builtin_amdgcn_sched_barrier(0);
    if (more) {
      u16* nb_ = sbase + (cur ^ 1) * (2 * 64 * 72);
      *(uint4*)(nb_ + srow * 72 + sch) = rk0;
      *(uint4*)(nb_ + (srow + 32) * 72 + sch) = rk1;
      *(uint4*)(nb_ + 64 * 72 + srow * 72 + sch) = rv0;
      *(uint4*)(nb_ + 64 * 72 + (srow + 32) * 72 + sch) = rv1;
    }
    __syncthreads();
  }
  float s1 = 0.f, s2 = 0.f;
  for (int k = 0; k < 32; ++k) { s1 += p.lq1[l * 32 + k] * p.lk1[l * 32 + k]; s2 += p.lq2[l * 32 + k] * p.lk2[l * 32 + k]; }
  const float lam_init = (l == 0) ? 0.2f : (0.8f - 0.6f * 0.74081822068171788f);
  const float lam = __expf(s1) - __expf(s2) + lam_init;
#pragma unroll
  for (int qt = 0; qt < 2; ++qt) {
    const float l0 = Ol[0][qt][0], l1 = Ol[1][qt][0];
    const float i0 = 1.0f / l0, i1 = lam / l1;
    float o[4][4];
    float ss = 0.f;
#pragma unroll
    for (int dt = 0; dt < 4; ++dt)
#pragma unroll
      for (int j = 0; j < 4; ++j) { o[dt][j] = O[0][dt][qt][j] * i0 - O[1][dt][qt][j] * i1; ss += o[dt][j] * o[dt][j]; }
    ss += __shfl_xor(ss, 16); ss += __shfl_xor(ss, 32);
    const float rs = rsqrtf(ss * (1.0f / 64.0f) + RMS_EPS) * (1.0f - lam_init);
    const int t = tb + q0 + 16 * qt + l15;
#pragma unroll
    for (int dt = 0; dt < 4; ++dt) {
      const int dd = 16 * dt + 4 * g;
      uint2 gz = *(const uint2*)(p.Z + (size_t)t * DIN + C_DG + 64 * h + dd);
      float4 gn = *(const float4*)(p.da_norm + l * 64 + dd);
      uint2 r;
      r.x = pack2_hw(o[dt][0] * rs * gn.x * siluf_(lo_f(gz.x)), o[dt][1] * rs * gn.y * siluf_(hi_f(gz.x)));
      r.y = pack2_hw(o[dt][2] * rs * gn.z * siluf_(lo_f(gz.y)), o[dt][3] * rs * gn.w * siluf_(hi_f(gz.y)));
      *(uint2*)(p.ACT + (size_t)t * DM + 768 + 64 * h + dd) = r;
    }
  }
}

__device__ void run_phase(const Params& p, int ph, unsigned char* smem) {
  if (ph == 0) { phase_prep(p, smem); return; }
  if (ph == NPHASE - 1) { phase_norm(p, 0, true); return; }
  const int l = (ph - 1) / 7, s = (ph - 1) % 7;
  switch (s) {
    case 0: phase_norm(p, l, false); break;
    case 1: phase_gemm_in(p, l, smem);
#if PROBE_DUP == 1
      phase_gemm_in(p, l, smem);
#endif
      break;
    case 2:
      phase_krope(p, l);
      phase_lru<false>(p, l, smem);
      break;
    case 3: {
      int* slot = (int*)(smem + 73728);
      for (;;) {
        __syncthreads();
        if (TIDX() == 0) *slot = (int)atomicAdd(p.CTR + l, 1u);
        __syncthreads();
        const int it = *slot;
#if PROBE_DUP == 4
        if (it >= 256 + 128 + 3072 * 2) break;
#else
        if (it >= 256 + 128 + 3072) break;
#endif
        if (it < 256) hgrn_item(p, l, it, smem);
        else if (it < 256 + 3072) attn_item(p, l, it - 256, smem);
        else lru_scan_item(p, it - 256 - 3072);
      }
      break;
    }
    case 4:
      phase_lru<true>(p, l, smem);
      phase_hgrn_combine(p, l);
#if PROBE_DUP == 5
      phase_lru<true>(p, l, smem);
#endif
#if PROBE_DUP == 15
      phase_hgrn_combine(p, l);
      phase_hgrn_combine(p, l);
      phase_hgrn_combine(p, l);
      phase_hgrn_combine(p, l);
#endif
      break;
    case 5: phase_gemm_out(p, l, smem); break;
    case 6: phase_gemm_ple(p, l, smem); break;
  }
}


#define XB_TMO      128
#define XB_XCNT(j)  (256  + 64 * (j))
#define XB_XSUB(j)  (1280 + 64 * (j))
#define XB_XGEN(j)  (2304 + 64 * (j))
#define XB_TOP      3328
#define XB_TOPGEN   3392
#define XCD_BAR_WORDS 3456
#define XB_SPIN_CAP (1u << 18)
#define LAS __attribute__((address_space(3)))
__device__ __forceinline__ unsigned xb_ld(unsigned* p)              { return __hip_atomic_load(p, __ATOMIC_RELAXED, __HIP_MEMORY_SCOPE_AGENT); }
__device__ __forceinline__ unsigned xb_add(unsigned* p, unsigned v) { return __hip_atomic_fetch_add(p, v, __ATOMIC_RELAXED, __HIP_MEMORY_SCOPE_AGENT); }
__device__ __forceinline__ unsigned xb_xcc_id() { return (unsigned)__builtin_amdgcn_s_getreg((3 << 11) | 20) & 0xFu; }
#define XB_SPIN(cond, bar) do { unsigned _sp = 0; while (cond) { __builtin_amdgcn_s_sleep(1); \
    if ((++_sp & 255u) == 0u) { if (xb_ld(&(bar)[XB_TMO])) break; if (_sp > XB_SPIN_CAP) { atomicAdd(&(bar)[XB_TMO], 1u); break; } } } } while (0)
struct XcdBarrier { unsigned* bar; unsigned x; volatile LAS unsigned* st; };
__device__ __forceinline__ XcdBarrier xcd_barrier_post(unsigned* bar, volatile LAS unsigned* st) {
  XcdBarrier b; b.bar = bar; b.x = xb_xcc_id(); b.st = st;
  if (threadIdx.x == 0) (void)xb_add(&bar[XB_XCNT(b.x)], 1u);
  return b;
}
__device__ __forceinline__ void xcd_barrier_complete(unsigned* bar, unsigned x, unsigned& nloc, unsigned& nx) {
  const unsigned G = gridDim.x * gridDim.y * gridDim.z;
  unsigned sum, cnt, mine, sp = 0u;
  for (;;) {
    sum = 0u; cnt = 0u; mine = 0u;
#pragma unroll
    for (unsigned j = 0; j < 16; ++j) { const unsigned c = xb_ld(&bar[XB_XCNT(j)]); sum += c; cnt += (c > 0u) ? 1u : 0u; mine = (j == x) ? c : mine; }
    if (sum == G) break;
    __builtin_amdgcn_s_sleep(1);
    if ((++sp & 255u) == 0u) { if (xb_ld(&bar[XB_TMO])) break; if (sp > XB_SPIN_CAP) { atomicAdd(&bar[XB_TMO], 1u); break; } }
  }
  nloc = mine > 0u ? mine : 1u; nx = cnt > 0u ? cnt : 1u;
}
__device__ __forceinline__ void xcd_barrier(const XcdBarrier& b) {
  asm volatile("s_waitcnt vmcnt(0)" ::: "memory");
  __syncthreads();
  if (threadIdx.x == 0) {
    unsigned* bar = b.bar;
    __builtin_amdgcn_s_waitcnt(0);
    unsigned nloc = b.st[0], nx = b.st[1];
    if (nloc == 0u) { xcd_barrier_complete(bar, b.x, nloc, nx); b.st[0] = nloc; b.st[1] = nx; }
    const unsigned old = xb_add(&bar[XB_XSUB(b.x)], 1u);
    const unsigned gen = old / nloc;
    if (old + 1u == (gen + 1u) * nloc) {
      __builtin_amdgcn_fence(__ATOMIC_RELEASE, "agent");
      asm volatile("s_waitcnt vmcnt(0)" ::: "memory");
      const unsigned og = xb_add(&bar[XB_TOP], 1u);
      const unsigned tg = og / nx;
      if (og + 1u == (tg + 1u) * nx) xb_add(&bar[XB_TOPGEN], 1u);
      else XB_SPIN(xb_ld(&bar[XB_TOPGEN]) == tg, bar);
      __builtin_amdgcn_fence(__ATOMIC_ACQUIRE, "agent");
      xb_add(&bar[XB_XGEN(b.x)], 1u);
      asm volatile("s_waitcnt vmcnt(0)" ::: "memory");
    } else {
      XB_SPIN(xb_ld(&bar[XB_XGEN(b.x)]) == gen, bar);
      __builtin_amdgcn_fence(__ATOMIC_ACQUIRE, "agent");
      asm volatile("s_waitcnt vmcnt(0)" ::: "memory");
    }
  }
  __syncthreads();
}

__global__ void __launch_bounds__(256, 2) mega(Params p) {
  extern __shared__ __attribute__((aligned(16))) unsigned char smem[];
  cg::grid_group grid = cg::this_grid();
  const bool multi = (p.phase_hi - p.phase_lo) > 1;
  XcdBarrier xb; xb.bar = p.BAR; xb.x = 0; xb.st = (volatile LAS unsigned*)(smem + 73736);
  if (multi) {
    if (threadIdx.x == 0) { xb.st[0] = 0u; xb.st[1] = 0u; }
    __syncthreads();
    xb = xcd_barrier_post(p.BAR, xb.st);
  }
  for (int ph = p.phase_lo; ph < p.phase_hi; ++ph) {
    if (ph > p.phase_lo) {
      if (ph == p.phase_lo + 1) grid.sync();
      else xcd_barrier(xb);
    }
    run_phase(p, ph, smem);
  }
}

extern "C" void kernel_launch(void* const* d_in, const int* in_sizes, int n_in, void* d_out, int out_size,
                              void* d_ws, size_t ws_size, hipStream_t stream) {
  static int grid_blocks = 0;
  if (!grid_blocks) {
    int dev = 0, cus = 0, per_cu = 0;
    hipGetDevice(&dev);
    hipDeviceGetAttribute(&cus, hipDeviceAttributeMultiprocessorCount, dev);
    hipFuncSetAttribute((const void*)mega, hipFuncAttributeMaxDynamicSharedMemorySize, LDS_BYTES);
    hipOccupancyMaxActiveBlocksPerMultiprocessor(&per_cu, (const void*)mega, 256, LDS_BYTES);
    if (per_cu < 1) per_cu = 1;
    if (per_cu > 2) per_cu = 2;
    grid_blocks = cus * per_cu;
  }
  Params p{};
  const float** fp = (const float**)&p;
  for (int i = 0; i < 24; ++i) fp[i] = (const float*)d_in[i];
  p.out = (float*)d_out;
  unsigned char* ws = (unsigned char*)d_ws;
  size_t off = 0;
  auto take = [&](size_t bytes) { unsigned char* r = ws + off; off += (bytes + 255) & ~(size_t)255; return r; };
  p.Z = (u16*)take((size_t)T_TOK * DIN * 2);
  p.ACT = (u16*)take((size_t)T_TOK * DM * 2);
  p.VT = (u16*)take((size_t)256 * T_TOK * 2);
  p.PB = (u16*)take((size_t)T_TOK * 256 * 2);
  p.CA = (float*)take((size_t)NCHUNK * 2 * 512 * 4);
  p.CB = (float*)take((size_t)NCHUNK * 2 * 512 * 4);
  p.WIN = (u16*)take((size_t)2 * DIN * DM * 2);
  p.WOUT = (u16*)take((size_t)2 * DM * DM * 2);
  p.WGATE = (u16*)take((size_t)2 * DM * DM * 2);
  p.WPLE = (u16*)take((size_t)2 * DM * 256 * 2);
  p.WLRU = (u16*)take((size_t)2 * 2 * 2 * 8 * 4096 * 2);
  p.ROPE = (float*)take((size_t)4096 * 8 * 4);
  p.SP8 = (float*)take((size_t)2 * 2 * 512 * 4);
  p.CTR = (unsigned*)take(256);
  p.KMAX = (unsigned*)take(2 * 256 * 4);
  p.BAR = (unsigned*)take((size_t)XCD_BAR_WORDS * 4);
  if (off > ws_size) { fprintf(stderr, "workspace too small: need %zu have %zu\n", off, ws_size); return; }
#if COOP
  p.phase_lo = 0; p.phase_hi = NPHASE;
  (void)hipMemsetAsync(p.BAR, 0, (size_t)XCD_BAR_WORDS * 4, stream);
  void* args[] = {&p};
  hipError_t e = hipLaunchCooperativeKernel((const void*)mega, dim3(grid_blocks), dim3(256), args, LDS_BYTES, stream);
  if (e != hipSuccess) fprintf(stderr, "cooperative launch failed: %s (grid %d)\n", hipGetErrorString(e), grid_blocks);
#else
  for (int ph = 0; ph < NPHASE; ++ph) {
    p.phase_lo = ph; p.phase_hi = ph + 1;
    hipLaunchKernelGGL(mega, dim3(grid_blocks), dim3(256), LDS_BYTES, stream, p);
  }
#endif
}
```

```cpp
#include <hip/hip_runtime.h>
#include <hip/hip_cooperative_groups.h>
#include <cstdio>
namespace cg = cooperative_groups;

#ifndef PROBE_DUP
#define PROBE_DUP 0
#endif
#ifndef COOP
#define COOP 1
#endif

typedef unsigned short u16;
typedef __attribute__((ext_vector_type(8))) short bf16x8;
typedef __attribute__((ext_vector_type(4))) float f32x4;

constexpr int T_TOK = 98304;
constexpr int T_PROMPT = 65536;
constexpr int DM = 1024;
constexpr int DIN = 3328;
constexpr int C_HQ = 0, C_HFF = 256, C_HFB = 512, C_HI = 768, C_HG = 1024, C_LX = 1280, C_LG = 1792,
              C_DQ = 2304, C_DK = 2560, C_DV = 2816, C_DG = 3072;
constexpr int NCHUNK = T_TOK / 64;
constexpr int LDS_BYTES = 73728 + 16;
constexpr int NPHASE = 1 + 7 * 2 + 1;
constexpr float RMS_EPS = 1e-6f;

struct Params {
  const float* x_prompt; const float* x_sample; const float* p_prompt; const float* p_sample;
  const float* norm_g; const float* w_in; const float* w_out; const float* hg_lb; const float* hg_norm;
  const float* conv_w; const float* conv_b; const float* wa; const float* ba; const float* wx; const float* bx;
  const float* lru_lam; const float* lq1; const float* lk1; const float* lq2; const float* lk2;
  const float* da_norm; const float* ple_w; const float* gate_w; const float* final_norm;
  float* out;
  u16* Z; u16* ACT; u16* VT; u16* PB; float* CA; float* CB;
  u16* WIN; u16* WOUT; u16* WGATE; u16* WPLE; u16* WLRU; float* ROPE; float* SP8; unsigned* CTR; unsigned* BAR; unsigned* KMAX;
  int phase_lo; int phase_hi;
};

__device__ __forceinline__ int TIDX() { int t = threadIdx.x; asm volatile("" : "+v"(t)); return t; }
__device__ __forceinline__ int BIDX() { int b = blockIdx.x; asm volatile("" : "+s"(b)); return b; }
__device__ __forceinline__ float bf2f(unsigned h) { return __uint_as_float(h << 16); }
__device__ __forceinline__ unsigned f2bf(float f) {
  return (unsigned)__builtin_bit_cast(unsigned short, (__bf16)f);
}
typedef __bf16 bf16x2_t __attribute__((ext_vector_type(2)));
typedef float f32x2_t __attribute__((ext_vector_type(2)));
__device__ __forceinline__ unsigned pack2(float a, float b) {
  f32x2_t v = {a, b};
  bf16x2_t r = __builtin_convertvector(v, bf16x2_t);
  return __builtin_bit_cast(unsigned, r);
}
__device__ __forceinline__ unsigned pack2_hw(float a, float b) { return pack2(a, b); }
__device__ __forceinline__ float lo_f(unsigned w) { return __uint_as_float(w << 16); }
__device__ __forceinline__ float hi_f(unsigned w) { return __uint_as_float(w & 0xffff0000u); }
__device__ __forceinline__ void unpack8(const uint4& v, float* x) {
  x[0] = lo_f(v.x); x[1] = hi_f(v.x); x[2] = lo_f(v.y); x[3] = hi_f(v.y);
  x[4] = lo_f(v.z); x[5] = hi_f(v.z); x[6] = lo_f(v.w); x[7] = hi_f(v.w);
}
__device__ __forceinline__ uint4 pack8(const float* x) {
  uint4 v; v.x = pack2_hw(x[0], x[1]); v.y = pack2_hw(x[2], x[3]); v.z = pack2_hw(x[4], x[5]); v.w = pack2_hw(x[6], x[7]);
  return v;
}
__device__ __forceinline__ bf16x8 as_bf8(const uint4& v) { return __builtin_bit_cast(bf16x8, v); }
__device__ __forceinline__ float sigmoidf_(float x) { return __builtin_amdgcn_rcpf(1.0f + __expf(-x)); }
__device__ __forceinline__ float siluf_(float x) { return x * __builtin_amdgcn_rcpf(1.0f + __expf(-x)); }
__device__ __forceinline__ f32x4 mfma16(bf16x8 a, bf16x8 b, f32x4 c) {
  return __builtin_amdgcn_mfma_f32_16x16x32_bf16(a, b, c, 0, 0, 0);
}
__device__ __forceinline__ int tok_pos(int t) { return t < T_PROMPT ? (t & 4095) : ((t - T_PROMPT) & 2047); }
__device__ __forceinline__ int tok_len(int t) { return t < T_PROMPT ? 4096 : 2048; }
__device__ __forceinline__ void seq_info(int seq, int& base, int& len) {
  if (seq < 16) { base = seq << 12; len = 4096; } else { base = T_PROMPT + ((seq - 16) << 11); len = 2048; }
}
__device__ __forceinline__ const float* x_row(const Params& p, int t) {
  return t < T_PROMPT ? p.x_prompt + (size_t)t * DM : p.x_sample + (size_t)(t - T_PROMPT) * DM;
}
__device__ __forceinline__ const float* p_row(const Params& p, int l, int t) {
  return t < T_PROMPT ? p.p_prompt + ((size_t)l * T_PROMPT + t) * 256
                      : p.p_sample + ((size_t)l * (T_TOK - T_PROMPT) + (t - T_PROMPT)) * 256;
}

struct TileIter { int v, end, step; };
__device__ __forceinline__ TileIter tile_iter(int NT) {
  int G = gridDim.x;
  TileIter it;
  if (G & 7) { it.v = BIDX(); it.end = NT; it.step = G; return it; }
  int per = (NT + 7) >> 3; int x = BIDX() & 7;
  it.v = x * per + (BIDX() >> 3); it.end = min((x + 1) * per, NT); it.step = G >> 3;
  return it;
}

__device__ void transpose_tile(const float* __restrict__ src, u16* __restrict__ dst, int K, int N, int tile, float* sm) {
  const int tid = TIDX();
  const int ntn = N >> 6;
  const int k0 = (tile / ntn) << 6, n0 = (tile % ntn) << 6;
  __syncthreads();
#pragma unroll
  for (int i = 0; i < 16; ++i) {
    int k = (tid >> 6) + 4 * i, n = tid & 63;
    sm[k * 65 + n] = src[(size_t)(k0 + k) * N + n0 + n];
  }
  __syncthreads();
#pragma unroll
  for (int i = 0; i < 16; ++i) {
    int n = (tid >> 6) + 4 * i, k = tid & 63;
    dst[(size_t)(n0 + n) * K + k0 + k] = (u16)f2bf(sm[k * 65 + n]);
  }
}

__device__ void phase_prep(const Params& p, unsigned char* smem) {
  float* sm = (float*)smem;
  for (int it = BIDX(); it < 2 * 1408; it += gridDim.x) {
    int l = it / 1408, r = it % 1408;
    if (r < 832) transpose_tile(p.w_in + (size_t)l * DM * DIN, p.WIN + (size_t)l * DIN * DM, DM, DIN, r, sm);
    else if (r < 1088) transpose_tile(p.w_out + (size_t)l * DM * DM, p.WOUT + (size_t)l * DM * DM, DM, DM, r - 832, sm);
    else if (r < 1344) transpose_tile(p.gate_w + (size_t)l * DM * DM, p.WGATE + (size_t)l * DM * DM, DM, DM, r - 1088, sm);
    else transpose_tile(p.ple_w + (size_t)l * 256 * DM, p.WPLE + (size_t)l * DM * 256, 256, DM, r - 1344, sm);
  }
  const int gt = BIDX() * 256 + TIDX(), gn = gridDim.x * 256;
  if (gt < 64) p.CTR[gt] = 0u;
  if (gt < 512) p.KMAX[gt] = 0u;
  for (int i = gt; i < 4096 * 4; i += gn) {
    int pos = i >> 2, k = i & 3;
    float inv = (k == 0) ? 1.0f : (k == 1) ? 0.037606030930863934f : (k == 2) ? 0.0014142135623730950f : 5.3183006600460594e-05f;
    float ang = (float)pos * inv;
    float nrev = rintf(ang * 0.15915494309189535f);
    float r = fmaf(-nrev, 6.28318548202514648f, ang);
    r = fmaf(-nrev, -1.74845553e-07f, r);
    p.ROPE[2 * i] = __cosf(r);
    p.ROPE[2 * i + 1] = __sinf(r);
  }
  for (int i = gt; i < 2 * 2 * 512; i += gn) {
    float nl = -p.lru_lam[i];
    p.SP8[i] = -8.0f * (fmaxf(nl, 0.f) + log1pf(__expf(-fabsf(nl))));
  }
  for (int i = gt; i < 2 * 2 * 2 * 8 * 4096; i += gn) {
    int c = i & 63, e = (i >> 6) & 63, blk = (i >> 12) & 7, mat = (i >> 15) & 1, d = (i >> 16) & 1, l = (i >> 17) & 1;
    const float* src = mat ? p.wx : p.wa;
    p.WLRU[i] = (u16)f2bf(src[((((size_t)(l * 2 + d) * 8 + blk) * 64 + c) * 64) + e]);
  }
}

__device__ void phase_norm(const Params& p, int l, bool fin) {
  const int lane = TIDX() & 63;
  const int gw = BIDX() * 4 + (TIDX() >> 6), nw = gridDim.x * 4;
  const float* g = fin ? p.final_norm : p.norm_g + l * DM;
  float4 gg[4];
#pragma unroll
  for (int i = 0; i < 4; ++i) gg[i] = ((const float4*)g)[lane + 64 * i];
  for (int row = gw; row < T_TOK; row += 2 * nw) {
    const int row2 = row + nw;
    const bool has2 = row2 < T_TOK;
    const float* src = (l == 0 && !fin) ? x_row(p, row) : p.out + (size_t)row * DM;
    const float* src2 = has2 ? ((l == 0 && !fin) ? x_row(p, row2) : p.out + (size_t)row2 * DM) : src;
    float4 v[4], u[4];
#pragma unroll
    for (int i = 0; i < 4; ++i) {
      typedef float f4v __attribute__((ext_vector_type(4)));
      const f4v a = __builtin_nontemporal_load((const f4v*)src + lane + 64 * i);
      const f4v b = __builtin_nontemporal_load((const f4v*)src2 + lane + 64 * i);
      v[i] = make_float4(a[0], a[1], a[2], a[3]); u[i] = make_float4(b[0], b[1], b[2], b[3]);
    }
    float ss = 0.f, ss2 = 0.f;
#pragma unroll
    for (int i = 0; i < 4; ++i) {
      ss += v[i].x * v[i].x + v[i].y * v[i].y + v[i].z * v[i].z + v[i].w * v[i].w;
      ss2 += u[i].x * u[i].x + u[i].y * u[i].y + u[i].z * u[i].z + u[i].w * u[i].w;
    }
#pragma unroll
    for (int o = 32; o >= 1; o >>= 1) { ss += __shfl_xor(ss, o); ss2 += __shfl_xor(ss2, o); }
    const float rs = rsqrtf(ss * (1.0f / 1024.0f) + RMS_EPS), rs2 = rsqrtf(ss2 * (1.0f / 1024.0f) + RMS_EPS);
#pragma unroll
    for (int i = 0; i < 4; ++i) {
      float4 y; y.x = v[i].x * rs * gg[i].x; y.y = v[i].y * rs * gg[i].y; y.z = v[i].z * rs * gg[i].z; y.w = v[i].w * rs * gg[i].w;
      float4 y2; y2.x = u[i].x * rs2 * gg[i].x; y2.y = u[i].y * rs2 * gg[i].y; y2.z = u[i].z * rs2 * gg[i].z; y2.w = u[i].w * rs2 * gg[i].w;
      if (fin) {
        typedef float f4v __attribute__((ext_vector_type(4)));
        const f4v ya = {y.x, y.y, y.z, y.w}, yb = {y2.x, y2.y, y2.z, y2.w};
        __builtin_nontemporal_store(ya, (f4v*)(p.out + (size_t)row * DM) + lane + 64 * i);
        if (has2) __builtin_nontemporal_store(yb, (f4v*)(p.out + (size_t)row2 * DM) + lane + 64 * i);
      } else {
        uint2 o2; o2.x = pack2_hw(y.x, y.y); o2.y = pack2_hw(y.z, y.w); ((uint2*)(p.ACT + (size_t)row * DM))[lane + 64 * i] = o2;
        if (has2) { uint2 o3; o3.x = pack2_hw(y2.x, y2.y); o3.y = pack2_hw(y2.z, y2.w); ((uint2*)(p.ACT + (size_t)row2 * DM))[lane + 64 * i] = o3; }
      }
    }
  }
  if (!fin) {
    const int total = T_TOK * 64;
    for (int i = BIDX() * 256 + TIDX(); i < total; i += gridDim.x * 256) {
      int t = i >> 6, c4 = i & 63;
      typedef float f4v __attribute__((ext_vector_type(4)));
      const f4v pv4 = __builtin_nontemporal_load((const f4v*)p_row(p, l, t) + c4);
      float4 v = make_float4(pv4[0], pv4[1], pv4[2], pv4[3]);
      uint2 o2; o2.x = pack2_hw(v.x, v.y); o2.y = pack2_hw(v.z, v.w);
      ((uint2*)(p.PB + (size_t)t * 256))[c4] = o2;
    }
  }
}

template <int NT>
__device__ __forceinline__ void gemm_mainloop(const u16* __restrict__ A, int lda, const u16* __restrict__ B, int ldb,
                                              int K, f32x4 (&acc)[4][NT], u16* sm) {
  static_assert(NT == 4, "only NT=4");
  const int tid = TIDX(), lane = tid & 63, w = tid >> 6, wm = w >> 1, wn = w & 1, l15 = lane & 15, g = lane >> 4;
  u16* sA = sm; u16* sB = sm + 2 * 128 * 72;
  const int lr = tid >> 3, lc = (tid & 7) * 8;
  const u16* ga = A + (size_t)lr * lda + lc;
  const u16* gb = B + (size_t)lr * ldb + lc;
  const size_t sa32 = (size_t)32 * lda, sb32 = (size_t)32 * ldb;
  uint4 ra0, ra1, ra2, ra3, rb0, rb1, rb2, rb3;
  ra0 = *(const uint4*)(ga); ra1 = *(const uint4*)(ga + sa32); ra2 = *(const uint4*)(ga + 2 * sa32); ra3 = *(const uint4*)(ga + 3 * sa32);
  rb0 = *(const uint4*)(gb); rb1 = *(const uint4*)(gb + sb32); rb2 = *(const uint4*)(gb + 2 * sb32); rb3 = *(const uint4*)(gb + 3 * sb32);
  {
    u16* wA = sA + lr * 72 + lc; u16* wB = sB + lr * 72 + lc;
    *(uint4*)(wA) = ra0; *(uint4*)(wA + 32 * 72) = ra1; *(uint4*)(wA + 64 * 72) = ra2; *(uint4*)(wA + 96 * 72) = ra3;
    *(uint4*)(wB) = rb0; *(uint4*)(wB + 32 * 72) = rb1; *(uint4*)(wB + 64 * 72) = rb2; *(uint4*)(wB + 96 * 72) = rb3;
  }
  __syncthreads();
  const int nk = K >> 6;
  for (int kt = 0; kt < nk; ++kt) {
    const int cur = kt & 1;
    const bool more = (kt + 1 < nk);
    if (more) {
      const u16* pa = ga + (kt + 1) * 64; const u16* pb = gb + (kt + 1) * 64;
      ra0 = *(const uint4*)(pa); ra1 = *(const uint4*)(pa + sa32); ra2 = *(const uint4*)(pa + 2 * sa32); ra3 = *(const uint4*)(pa + 3 * sa32);
      rb0 = *(const uint4*)(pb); rb1 = *(const uint4*)(pb + sb32); rb2 = *(const uint4*)(pb + 2 * sb32); rb3 = *(const uint4*)(pb + 3 * sb32);
    }
    __builtin_amdgcn_sched_barrier(0);
    const u16* cA = sA + cur * 128 * 72 + (wm * 64 + l15) * 72 + g * 8;
    const u16* cB = sB + cur * 128 * 72 + (wn * 64 + l15) * 72 + g * 8;
#pragma unroll
    for (int ks = 0; ks < 2; ++ks) {
      bf16x8 af[4], bfr[4];
#pragma unroll
      for (int i = 0; i < 4; ++i) {
        af[i] = *(const bf16x8*)(cA + i * 16 * 72 + ks * 32);
        bfr[i] = *(const bf16x8*)(cB + i * 16 * 72 + ks * 32);
      }
#pragma unroll
      for (int mt = 0; mt < 4; ++mt)
#pragma unroll
        for (int nt = 0; nt < 4; ++nt) acc[mt][nt] = mfma16(bfr[nt], af[mt], acc[mt][nt]);
    }
    __builtin_amdgcn_sched_barrier(0);
    if (more) {
      u16* wA = sA + (cur ^ 1) * 128 * 72 + lr * 72 + lc; u16* wB = sB + (cur ^ 1) * 128 * 72 + lr * 72 + lc;
      *(uint4*)(wA) = ra0; *(uint4*)(wA + 32 * 72) = ra1; *(uint4*)(wA + 64 * 72) = ra2; *(uint4*)(wA + 96 * 72) = ra3;
      *(uint4*)(wB) = rb0; *(uint4*)(wB + 32 * 72) = rb1; *(uint4*)(wB + 64 * 72) = rb2; *(uint4*)(wB + 96 * 72) = rb3;
    }
    __syncthreads();
  }
}

__device__ __forceinline__ void gemm_mainloop2(const u16* __restrict__ A, int lda, const u16* __restrict__ B, int ldb,
                                               int K, f32x4 (&acc)[4][8], u16* sm) {
  const int tid = TIDX(), lane = tid & 63, w = tid >> 6, wm = w >> 1, wn = w & 1, l15 = lane & 15, g = lane >> 4;
  constexpr int SZ = 384 * 40;
  const int lr = tid >> 2, lc = (tid & 3) * 8;
  const u16* ga = A + (size_t)lr * lda + lc;
  const u16* gb = B + (size_t)lr * ldb + lc;
  const size_t sa64 = (size_t)64 * lda, sb64 = (size_t)64 * ldb;
  uint4 ra0, ra1, rb0, rb1, rb2, rb3;
  ra0 = *(const uint4*)(ga); ra1 = *(const uint4*)(ga + sa64);
  rb0 = *(const uint4*)(gb); rb1 = *(const uint4*)(gb + sb64); rb2 = *(const uint4*)(gb + 2 * sb64); rb3 = *(const uint4*)(gb + 3 * sb64);
  {
    u16* wA = sm + lr * 40 + lc; u16* wB = sm + 128 * 40 + lr * 40 + lc;
    *(uint4*)(wA) = ra0; *(uint4*)(wA + 64 * 40) = ra1;
    *(uint4*)(wB) = rb0; *(uint4*)(wB + 64 * 40) = rb1; *(uint4*)(wB + 128 * 40) = rb2; *(uint4*)(wB + 192 * 40) = rb3;
  }
  __syncthreads();
  const int nk = K >> 5;
  for (int kt = 0; kt < nk; ++kt) {
    const int cur = kt & 1;
    const bool more = (kt + 1 < nk);
    if (more) {
      const u16* pa = ga + (kt + 1) * 32; const u16* pb = gb + (kt + 1) * 32;
      ra0 = *(const uint4*)(pa); ra1 = *(const uint4*)(pa + sa64);
      rb0 = *(const uint4*)(pb); rb1 = *(const uint4*)(pb + sb64); rb2 = *(const uint4*)(pb + 2 * sb64); rb3 = *(const uint4*)(pb + 3 * sb64);
    }
    __builtin_amdgcn_sched_barrier(0);
    const u16* cA = sm + cur * SZ + (wm * 64 + l15) * 40 + g * 8;
    const u16* cB = sm + cur * SZ + 128 * 40 + (wn * 128 + l15) * 40 + g * 8;
    bf16x8 af[4];
#pragma unroll
    for (int i = 0; i < 4; ++i) af[i] = *(const bf16x8*)(cA + i * 16 * 40);
#pragma unroll
    for (int nh = 0; nh < 2; ++nh) {
      bf16x8 bfr[4];
#pragma unroll
      for (int i = 0; i < 4; ++i) bfr[i] = *(const bf16x8*)(cB + (nh * 4 + i) * 16 * 40);
#pragma unroll
      for (int mt = 0; mt < 4; ++mt)
#pragma unroll
        for (int nt = 0; nt < 4; ++nt) acc[mt][nh * 4 + nt] = mfma16(bfr[nt], af[mt], acc[mt][nh * 4 + nt]);
    }
    __builtin_amdgcn_sched_barrier(0);
    if (more) {
      u16* wA = sm + (cur ^ 1) * SZ + lr * 40 + lc; u16* wB = sm + (cur ^ 1) * SZ + 128 * 40 + lr * 40 + lc;
      *(uint4*)(wA) = ra0; *(uint4*)(wA + 64 * 40) = ra1;
      *(uint4*)(wB) = rb0; *(uint4*)(wB + 64 * 40) = rb1; *(uint4*)(wB + 128 * 40) = rb2; *(uint4*)(wB + 192 * 40) = rb3;
    }
    __syncthreads();
  }
}

__device__ __forceinline__ void gemm_mainloop3(const u16* __restrict__ A, int lda, const u16* __restrict__ B, int ldb,
                                               int K, f32x4 (&acc)[4][8], unsigned char* smb) {
  const int tid = TIDX(), lane = tid & 63, w = tid >> 6, wm = w >> 1, wn = w & 1, l15 = lane & 15, g = lane >> 4;
  constexpr int STG = 24576;
  const int rowt = tid >> 2;
  const int cl = ((tid & 3) ^ (((tid >> 5) & 1) << 1)) * 8;
  const u16* ga = A + (size_t)rowt * lda + cl;
  const u16* gb = B + (size_t)rowt * ldb + cl;
  const size_t sa64 = (size_t)64 * lda, sb64 = (size_t)64 * ldb;
  unsigned char* wbase = smb + w * 1024;
#define GLDS16(gp, lp) __builtin_amdgcn_global_load_lds((const unsigned*)(gp), (unsigned*)(lp), 16, 0, 0)
#define ISSUE_TILE(kt_, stg_) do { \
    unsigned char* sb_ = wbase + (stg_) * STG; const u16* pa_ = ga + (kt_) * 32; const u16* pb_ = gb + (kt_) * 32; \
    GLDS16(pa_, sb_); GLDS16(pa_ + sa64, sb_ + 4096); \
    GLDS16(pb_, sb_ + 8192); GLDS16(pb_ + sb64, sb_ + 8192 + 4096); \
    GLDS16(pb_ + 2 * sb64, sb_ + 8192 + 8192); GLDS16(pb_ + 3 * sb64, sb_ + 8192 + 12288); } while (0)
  ISSUE_TILE(0, 0);
  asm volatile("s_waitcnt vmcnt(0)" ::: "memory");
  __syncthreads();
  const int csw = (g ^ (((l15 >> 3) & 1) << 1)) * 16;
  const int nk = K >> 5;
  for (int kt = 0; kt < nk; ++kt) {
    const int cur = kt & 1;
    if (kt + 1 < nk) ISSUE_TILE(kt + 1, cur ^ 1);
    __builtin_amdgcn_sched_barrier(0);
    const unsigned char* cA = smb + cur * STG + (wm * 64 + l15) * 64 + csw;
    const unsigned char* cB = smb + cur * STG + 8192 + (wn * 128 + l15) * 64 + csw;
    bf16x8 af[4];
#pragma unroll
    for (int i = 0; i < 4; ++i) af[i] = *(const bf16x8*)(cA + i * 16 * 64);
#pragma unroll
    for (int nh = 0; nh < 2; ++nh) {
      bf16x8 bfr[4];
#pragma unroll
      for (int i = 0; i < 4; ++i) bfr[i] = *(const bf16x8*)(cB + (nh * 4 + i) * 16 * 64);
#pragma unroll
      for (int nt = 0; nt < 4; ++nt)
#pragma unroll
        for (int mt = 0; mt < 4; ++mt) acc[mt][nh * 4 + nt] = mfma16(bfr[nt], af[mt], acc[mt][nh * 4 + nt]);
    }
    __builtin_amdgcn_sched_group_barrier(0x100, 6, 0);
#pragma unroll
    for (int i = 0; i < 6; ++i) {
      __builtin_amdgcn_sched_group_barrier(0x008, 4, 0);
      __builtin_amdgcn_sched_group_barrier(0x100, 1, 0);
    }
    __builtin_amdgcn_sched_group_barrier(0x008, 8, 0);
    __builtin_amdgcn_sched_barrier(0);
    asm volatile("s_waitcnt vmcnt(0)" ::: "memory");
    __syncthreads();
  }
#undef ISSUE_TILE
#undef GLDS16
}

__device__ __forceinline__ void gemm_mainloop4(const u16* __restrict__ A, int lda, const u16* __restrict__ B, int ldb,
                                               int K, f32x4 (&acc)[4][4], unsigned char* smb) {
  const int tid = TIDX(), lane = tid & 63, w = tid >> 6, wm = w >> 1, wn = w & 1, l15 = lane & 15, g = lane >> 4;
  constexpr int STG = 32768;
  const int rowt = tid >> 2;
  const int cl = ((tid & 3) ^ (((tid >> 5) & 1) << 1)) * 8;
  const u16* ga = A + (size_t)rowt * lda + cl;
  const u16* gb = B + (size_t)rowt * ldb + cl;
  const size_t sa64 = (size_t)64 * lda, sb64 = (size_t)64 * ldb;
  unsigned char* wbase = smb + w * 1024;
#define GLDS16(gp, lp) __builtin_amdgcn_global_load_lds((const unsigned*)(gp), (unsigned*)(lp), 16, 0, 0)
#define ISSUE_TILE4(kt_, stg_) do { \
    unsigned char* sb_ = wbase + (stg_) * STG; const u16* pa_ = ga + (kt_) * 64; const u16* pb_ = gb + (kt_) * 64; \
    GLDS16(pa_, sb_); GLDS16(pa_ + sa64, sb_ + 4096); \
    GLDS16(pa_ + 32, sb_ + 8192); GLDS16(pa_ + sa64 + 32, sb_ + 8192 + 4096); \
    GLDS16(pb_, sb_ + 16384); GLDS16(pb_ + sb64, sb_ + 16384 + 4096); \
    GLDS16(pb_ + 32, sb_ + 24576); GLDS16(pb_ + sb64 + 32, sb_ + 24576 + 4096); } while (0)
  __syncthreads();
  ISSUE_TILE4(0, 0);
  asm volatile("s_waitcnt vmcnt(0)" ::: "memory");
  __syncthreads();
  const int csw = (g ^ (((l15 >> 3) & 1) << 1)) * 16;
  const int nk = K >> 6;
  for (int kt = 0; kt < nk; ++kt) {
    const int cur = kt & 1;
    if (kt + 1 < nk) ISSUE_TILE4(kt + 1, cur ^ 1);
#pragma unroll
    for (int ks = 0; ks < 2; ++ks) {
      const unsigned char* cA = smb + cur * STG + ks * 8192 + (wm * 64 + l15) * 64 + csw;
      const unsigned char* cB = smb + cur * STG + 16384 + ks * 8192 + (wn * 64 + l15) * 64 + csw;
      bf16x8 af[4], bfr[4];
#pragma unroll
      for (int i = 0; i < 4; ++i) { af[i] = *(const bf16x8*)(cA + i * 1024); bfr[i] = *(const bf16x8*)(cB + i * 1024); }
#pragma unroll
      for (int nt = 0; nt < 4; ++nt)
#pragma unroll
        for (int mt = 0; mt < 4; ++mt) acc[mt][nt] = mfma16(bfr[nt], af[mt], acc[mt][nt]);
    }
    asm volatile("s_waitcnt vmcnt(0)" ::: "memory");
    __syncthreads();
  }
#undef ISSUE_TILE4
#undef GLDS16
}

__device__ __forceinline__ void acc2_to_lds(const f32x4 (&acc)[4][8], float* ct, int hf) {
  const int tid = TIDX(), lane = tid & 63, w = tid >> 6, wm = w >> 1, wn = w & 1, l15 = lane & 15, g = lane >> 4;
#pragma unroll
  for (int mt = 0; mt < 4; ++mt)
#pragma unroll
    for (int nt = 0; nt < 4; ++nt)
      *(f32x4*)(ct + (wm * 64 + mt * 16 + l15) * 132 + wn * 64 + nt * 16 + 4 * g) = acc[mt][hf * 4 + nt];
  __syncthreads();
}

__device__ __forceinline__ void tile_mn(int v, int ntn, int bn, int& m0, int& n0) {
  int grp = v / (8 * ntn), r = v % (8 * ntn);
  m0 = (grp * 8 + (r & 7)) * 128; n0 = (r >> 3) * bn;
}

#define ZERO_ACC(acc) _Pragma("unroll") for (int _a = 0; _a < 4; ++_a) _Pragma("unroll") for (int _b = 0; _b < 4; ++_b) acc[_a][_b] = f32x4{0.f, 0.f, 0.f, 0.f};

__device__ __forceinline__ void acc_to_lds(const f32x4 (&acc)[4][4], float* ct) {
  const int tid = TIDX(), lane = tid & 63, w = tid >> 6, wm = w >> 1, wn = w & 1, l15 = lane & 15, g = lane >> 4;
#pragma unroll
  for (int mt = 0; mt < 4; ++mt)
#pragma unroll
    for (int nt = 0; nt < 4; ++nt)
      *(f32x4*)(ct + (wm * 64 + mt * 16 + l15) * 132 + wn * 64 + nt * 16 + 4 * g) = acc[mt][nt];
  __syncthreads();
}

__device__ void phase_gemm_in(const Params& p, int l, unsigned char* smem) {
  const int ntn = DIN / 256;
  float* ct = (float*)smem;
  TileIter it = tile_iter((T_TOK / 128) * ntn);
  for (int v = it.v; v < it.end; v += it.step) {
    int m0, n0; tile_mn(v, ntn, 256, m0, n0);
    f32x4 acc[4][8];
#pragma unroll
    for (int a = 0; a < 4; ++a)
#pragma unroll
      for (int b = 0; b < 8; ++b) acc[a][b] = f32x4{0.f, 0.f, 0.f, 0.f};
    gemm_mainloop3(p.ACT + (size_t)m0 * DM, DM, p.WIN + (size_t)l * DIN * DM + (size_t)n0 * DM, DM, DM, acc, smem);
    const int tid = TIDX();
    const bool dv = (n0 >= C_DV && n0 < C_DG);
#pragma unroll
    for (int hf = 0; hf < 2; ++hf) {
      acc2_to_lds(acc, ct, hf);
      if (!dv) {
#pragma unroll
        for (int i = 0; i < 16; ++i) {
          int idx = tid + 256 * i, r = idx >> 5, c4 = idx & 31;
          float4 x = *(const float4*)(ct + r * 132 + 4 * c4);
          uint2 o2; o2.x = pack2(x.x, x.y); o2.y = pack2(x.z, x.w);
          { typedef unsigned u2v __attribute__((ext_vector_type(2))); const u2v o_ = {o2.x, o2.y};
            __builtin_nontemporal_store(o_, (u2v*)(p.Z + (size_t)(m0 + r) * DIN + n0 + (c4 >> 4) * 128 + hf * 64 + (c4 & 15) * 4)); }
        }
      } else {
#pragma unroll
        for (int i = 0; i < 16; ++i) {
          int idx = tid + 256 * i, n = idx >> 5, m4 = idx & 31;
          uint2 o2;
          o2.x = pack2(ct[(4 * m4 + 0) * 132 + n], ct[(4 * m4 + 1) * 132 + n]);
          o2.y = pack2(ct[(4 * m4 + 2) * 132 + n], ct[(4 * m4 + 3) * 132 + n]);
          const int ng = n0 + (n >> 6) * 128 + hf * 64 + (n & 63);
          *(uint2*)(p.VT + (size_t)(ng - C_DV) * T_TOK + m0 + 4 * m4) = o2;
        }
      }
      __syncthreads();
    }
  }
}

__device__ void phase_gemm_out(const Params& p, int l, unsigned char* smem, bool dry = false) {
  const int ntn = DM / 256;
  u16* H1B = p.Z;
  float* ct = (float*)smem;
  TileIter it = tile_iter((T_TOK / 128) * ntn);
  for (int v = it.v; v < it.end; v += it.step) {
    int m0, n0; tile_mn(v, ntn, 256, m0, n0);
    f32x4 acc[4][8];
#pragma unroll
    for (int a = 0; a < 4; ++a)
#pragma unroll
      for (int b = 0; b < 8; ++b) acc[a][b] = f32x4{0.f, 0.f, 0.f, 0.f};
    gemm_mainloop3(p.ACT + (size_t)m0 * DM, DM, p.WOUT + (size_t)l * DM * DM + (size_t)n0 * DM, DM, DM, acc, smem);
    const int tid = TIDX();
#pragma unroll
    for (int hf = 0; hf < 2; ++hf) {
      acc2_to_lds(acc, ct, hf);
#pragma unroll
      for (int i = 0; i < 16; ++i) {
        int idx = tid + 256 * i, r = idx >> 5, c4 = idx & 31;
        const int m = m0 + r, n = n0 + (c4 >> 4) * 128 + hf * 64 + (c4 & 15) * 4;
        float4 x = *(const float4*)(ct + r * 132 + 4 * c4);
        const float* hp = (l == 0) ? x_row(p, m) + n : p.out + (size_t)m * DM + n;
        typedef float f4v __attribute__((ext_vector_type(4)));
        const f4v hnt = __builtin_nontemporal_load((const f4v*)hp);
        float4 hv = make_float4(hnt[0], hnt[1], hnt[2], hnt[3]);
        float4 rr; rr.x = hv.x + x.x; rr.y = hv.y + x.y; rr.z = hv.z + x.z; rr.w = hv.w + x.w;
        if (!dry) {
          *(float4*)(p.out + (size_t)m * DM + n) = rr;
          uint2 o2; o2.x = pack2(rr.x, rr.y); o2.y = pack2(rr.z, rr.w);
          *(uint2*)(H1B + (size_t)m * DM + n) = o2;
        }
      }
      __syncthreads();
    }
  }
}

__device__ void phase_gemm_ple(const Params& p, int l, unsigned char* smem, bool dry = false) {
  const int ntn = DM / 128;
  const u16* H1B = p.Z;
  float* ct = (float*)smem;
  TileIter it = tile_iter((T_TOK / 128) * ntn);
  for (int v = it.v; v < it.end; v += it.step) {
    int m0, n0; tile_mn(v, ntn, 128, m0, n0);
    f32x4 acc[4][4]; ZERO_ACC(acc);
    gemm_mainloop4(H1B + (size_t)m0 * DM, DM, p.WGATE + (size_t)l * DM * DM + (size_t)n0 * DM, DM, DM, acc, smem);
    unsigned gpk[4][4][2];
#pragma unroll
    for (int mt = 0; mt < 4; ++mt)
#pragma unroll
      for (int nt = 0; nt < 4; ++nt) {
        gpk[mt][nt][0] = pack2_hw(sigmoidf_(acc[mt][nt][0]), sigmoidf_(acc[mt][nt][1]));
        gpk[mt][nt][1] = pack2_hw(sigmoidf_(acc[mt][nt][2]), sigmoidf_(acc[mt][nt][3]));
      }
    ZERO_ACC(acc);
    gemm_mainloop4(p.PB + (size_t)m0 * 256, 256, p.WPLE + (size_t)l * DM * 256 + (size_t)n0 * 256, 256, 256, acc, smem);
#pragma unroll
    for (int mt = 0; mt < 4; ++mt)
#pragma unroll
      for (int nt = 0; nt < 4; ++nt) {
        acc[mt][nt][0] *= lo_f(gpk[mt][nt][0]); acc[mt][nt][1] *= hi_f(gpk[mt][nt][0]);
        acc[mt][nt][2] *= lo_f(gpk[mt][nt][1]); acc[mt][nt][3] *= hi_f(gpk[mt][nt][1]);
      }
    acc_to_lds(acc, ct);
    const int tid = TIDX();
#pragma unroll
    for (int i = 0; i < 16; ++i) {
      int idx = tid + 256 * i, r = idx >> 5, c4 = idx & 31;
      float4 x = *(const float4*)(ct + r * 132 + 4 * c4);
      float* hp = p.out + (size_t)(m0 + r) * DM + n0 + 4 * c4;
      typedef float f4v __attribute__((ext_vector_type(4)));
      const f4v hnt = __builtin_nontemporal_load((const f4v*)hp);
      float4 hv = make_float4(hnt[0], hnt[1], hnt[2], hnt[3]);
      hv.x += x.x; hv.y += x.y; hv.z += x.z; hv.w += x.w;
      if (!dry) *(float4*)hp = hv;
    }
    __syncthreads();
  }
}

__device__ void phase_krope(const Params& p, int l) {
  for (int i = BIDX() * 256 + TIDX(); i < T_TOK * 8; i += gridDim.x * 256) {
    int t = i >> 3, hh = i & 7;
    u16* ptr = p.Z + (size_t)t * DIN + C_DK + hh * 32;
    uint4 raw = *(const uint4*)ptr;
    uint4 r1 = *(const uint4*)(ptr + 8), r2 = *(const uint4*)(ptr + 16), r3 = *(const uint4*)(ptr + 24);
    float x[8], y[8]; unpack8(raw, x);
    const float* rt = p.ROPE + (size_t)tok_pos(t) * 8;
#pragma unroll
    for (int k = 0; k < 4; ++k) {
      float c = rt[2 * k], s = rt[2 * k + 1];
      y[k] = x[k] * c - x[k + 4] * s;
      y[k + 4] = x[k + 4] * c + x[k] * s;
    }
    *(uint4*)ptr = pack8(y);
    float k2 = 0.f;
#pragma unroll
    for (int k = 0; k < 8; ++k) k2 += x[k] * x[k];
    float z[8];
    unpack8(r1, z);
#pragma unroll
    for (int k = 0; k < 8; ++k) k2 += z[k] * z[k];
    unpack8(r2, z);
#pragma unroll
    for (int k = 0; k < 8; ++k) k2 += z[k] * z[k];
    unpack8(r3, z);
#pragma unroll
    for (int k = 0; k < 8; ++k) k2 += z[k] * z[k];
    k2 = fmaxf(k2, __shfl_xor(k2, 8));
    k2 = fmaxf(k2, __shfl_xor(k2, 16));
    k2 = fmaxf(k2, __shfl_xor(k2, 32));
    if ((TIDX() & 63) < 8) {
      const int seq = t < T_PROMPT ? (t >> 12) : 16 + ((t - T_PROMPT) >> 11);
      atomicMax(p.KMAX + (l * 32 + seq) * 8 + hh, __float_as_uint(k2));
    }
  }
}

template <bool FINAL>
__device__ void phase_lru(const Params& p, int l, unsigned char* smem) {
  u16* xs = (u16*)smem;
  float* u32 = (float*)(smem + 8704);
  u16* ub = (u16*)(smem + 25088);
  float* sa = (float*)(smem + 34304);
  float* sb = (float*)(smem + 50688);
  float* part = (float*)(smem + 67072);
  const int tid = TIDX(), lane = tid & 63, w = tid >> 6, l15 = lane & 15, g = lane >> 4;
  const int e_ = tid & 63, qd = tid >> 6;
  const int NIT = NCHUNK * 8;
  const int step = gridDim.x;
  int it = BIDX();
  uint4 x0 = make_uint4(0, 0, 0, 0), x1 = x0, x2 = x0;
  auto load_x = [&](int item, uint4& a0, uint4& a1, uint4& a2) {
    const int ci = item >> 3, nb = item & 7;
    const int tb = ci * 64, pos0 = tok_pos(tb), S = tok_len(tb);
    const u16* zb = p.Z + (long)(tb - 2) * DIN + C_LX + nb * 64;
    { int idx = tid, r = idx >> 3, ch = idx & 7, pp = pos0 - 2 + r;
      a0 = (pp >= 0 && pp < S) ? *(const uint4*)(zb + (long)r * DIN + ch * 8) : make_uint4(0, 0, 0, 0); }
    { int idx = tid + 256, r = idx >> 3, ch = idx & 7, pp = pos0 - 2 + r;
      a1 = (pp >= 0 && pp < S) ? *(const uint4*)(zb + (long)r * DIN + ch * 8) : make_uint4(0, 0, 0, 0); }
    { int idx = tid + 512, r = idx >> 3, ch = idx & 7, pp = pos0 - 2 + r;
      a2 = (idx < 67 * 8 && pp >= 0 && pp < S) ? *(const uint4*)(zb + (long)r * DIN + ch * 8) : make_uint4(0, 0, 0, 0); }
  };
  if (it < NIT) load_x(it, x0, x1, x2);
  for (; it < NIT; it += step) {
    const int ci = it >> 3, nb = it & 7;
    const int tb = ci * 64;
    __syncthreads();
    *(uint4*)(xs + (tid >> 3) * 64 + (tid & 7) * 8) = x0;
    *(uint4*)(xs + ((tid + 256) >> 3) * 64 + (tid & 7) * 8) = x1;
    if (tid + 512 < 67 * 8) *(uint4*)(xs + ((tid + 512) >> 3) * 64 + (tid & 7) * 8) = x2;
    uint4 gz0 = make_uint4(0, 0, 0, 0), gz1 = gz0;
    float cin0 = 0.f, cin1 = 0.f;
    if (FINAL) {
      const u16* gb = p.Z + (size_t)tb * DIN + C_LG + nb * 64 + (tid & 7) * 8;
      typedef unsigned u4v __attribute__((ext_vector_type(4)));
      const u4v g0_ = __builtin_nontemporal_load((const u4v*)(gb + (size_t)(tid >> 3) * DIN));
      const u4v g1_ = __builtin_nontemporal_load((const u4v*)(gb + (size_t)((tid >> 3) + 32) * DIN));
      gz0 = make_uint4(g0_[0], g0_[1], g0_[2], g0_[3]);
      gz1 = make_uint4(g1_[0], g1_[1], g1_[2], g1_[3]);
      cin0 = p.CB[((size_t)ci * 2 + 0) * 512 + nb * 64 + e_];
      cin1 = p.CB[((size_t)ci * 2 + 1) * 512 + nb * 64 + e_];
    }
    __syncthreads();
    if (it + step < NIT) load_x(it + step, x0, x1, x2);
    {
      const int ch = nb * 64 + e_;
      const float cw0 = p.conv_w[(l * 4 + 0) * 512 + ch], cw1 = p.conv_w[(l * 4 + 1) * 512 + ch],
                  cw2 = p.conv_w[(l * 4 + 2) * 512 + ch], cw3 = p.conv_w[(l * 4 + 3) * 512 + ch];
      const float cb = p.conv_b[l * 512 + ch];
      float xv[19];
#pragma unroll
      for (int k = 0; k < 19; ++k) xv[k] = bf2f(xs[(qd * 16 + k) * 64 + e_]);
#pragma unroll
      for (int tt = 0; tt < 16; ++tt) {
        const int t = qd * 16 + tt;
        const float u = cb + xv[tt] * cw0 + xv[tt + 1] * cw1 + xv[tt + 2] * cw2 + xv[tt + 3] * cw3;
        u32[t * 64 + e_] = u;
        ub[t * 72 + e_] = (u16)f2bf(u);
      }
    }
    __syncthreads();
    if (FINAL) {
      *(uint4*)(xs + (tid >> 3) * 64 + (tid & 7) * 8) = gz0;
      *(uint4*)(xs + ((tid >> 3) + 32) * 64 + (tid & 7) * 8) = gz1;
    }
    float hsum[16];
#pragma unroll
    for (int tt = 0; tt < 16; ++tt) hsum[tt] = 0.f;
#pragma unroll
    for (int d = 0; d < 2; ++d) {
      {
        bf16x8 uf[2];
        uf[0] = *(const bf16x8*)(ub + (16 * w + l15) * 72 + g * 8);
        uf[1] = *(const bf16x8*)(ub + (16 * w + l15) * 72 + 32 + g * 8);
        const int t = 16 * w + l15;
#pragma unroll
        for (int et = 0; et < 4; ++et) {
          f32x4 ar = {0.f, 0.f, 0.f, 0.f}, ai = {0.f, 0.f, 0.f, 0.f};
          const u16* wr = p.WLRU + ((((size_t)(l * 2 + d) * 2 + 0) * 8 + nb) * 64 + et * 16 + l15) * 64 + g * 8;
          const u16* wi = p.WLRU + ((((size_t)(l * 2 + d) * 2 + 1) * 8 + nb) * 64 + et * 16 + l15) * 64 + g * 8;
#pragma unroll
          for (int ks = 0; ks < 2; ++ks) {
            ar = mfma16(*(const bf16x8*)(wr + ks * 32), uf[ks], ar);
            ai = mfma16(*(const bf16x8*)(wi + ks * 32), uf[ks], ai);
          }
          const int e0 = et * 16 + 4 * g, ch0 = nb * 64 + e0;
          const float4 ba4 = *(const float4*)(p.ba + (l * 2 + d) * 512 + ch0);
          const float4 bx4 = *(const float4*)(p.bx + (l * 2 + d) * 512 + ch0);
          const float4 sp4 = *(const float4*)(p.SP8 + (l * 2 + d) * 512 + ch0);
          const float4 uu = *(const float4*)(u32 + t * 64 + e0);
          const float* bap = (const float*)&ba4; const float* bxp = (const float*)&bx4;
          const float* spp = (const float*)&sp4; const float* uup = (const float*)&uu;
          f32x4 av, bv;
#pragma unroll
          for (int j = 0; j < 4; ++j) {
            float r = sigmoidf_(ar[j] + bap[j]);
            float ig = sigmoidf_(ai[j] + bxp[j]);
            float la = spp[j] * r;
            float av_ = __expf(la);
            float t2 = 2.0f * la;
            float ser = -t2 * (1.f + t2 * 0.5f * (1.f + t2 * (1.f / 3.f) * (1.f + t2 * 0.25f * (1.f + t2 * 0.2f))));
            float om = (t2 > -0.25f) ? ser : (1.0f - av_ * av_);
            av[j] = av_;
            bv[j] = __builtin_amdgcn_sqrtf(om) * ig * uup[j];
          }
          *(f32x4*)(sa + t * 64 + e0) = av;
          *(f32x4*)(sb + t * 64 + e0) = bv;
        }
      }
      __syncthreads();
      {
        float A = 1.f, B = 0.f;
        if (d == 0) {
#pragma unroll
          for (int tt = 0; tt < 16; ++tt) { int t = qd * 16 + tt; float a = sa[t * 64 + e_], b = sb[t * 64 + e_]; B = a * B + b; A *= a; }
        } else {
#pragma unroll
          for (int tt = 15; tt >= 0; --tt) { int t = qd * 16 + tt; float a = sa[t * 64 + e_], b = sb[t * 64 + e_]; B = a * B + b; A *= a; }
        }
        part[(0 * 4 + qd) * 64 + e_] = A;
        part[(1 * 4 + qd) * 64 + e_] = B;
      }
      __syncthreads();
      if (!FINAL) {
        if (qd == 0) {
          float A = 1.f, B = 0.f;
          if (d == 0) {
#pragma unroll
            for (int q = 0; q < 4; ++q) { float aq = part[q * 64 + e_], bq = part[(4 + q) * 64 + e_]; B = aq * B + bq; A *= aq; }
          } else {
#pragma unroll
            for (int q = 3; q >= 0; --q) { float aq = part[q * 64 + e_], bq = part[(4 + q) * 64 + e_]; B = aq * B + bq; A *= aq; }
          }
          const size_t cidx = ((size_t)ci * 2 + d) * 512 + nb * 64 + e_;
          p.CA[cidx] = A; p.CB[cidx] = B;
        }
      } else {
        float h = d ? cin1 : cin0;
        if (d == 0) {
#pragma unroll
          for (int q = 0; q < 4; ++q) if (q < qd) h = part[q * 64 + e_] * h + part[(4 + q) * 64 + e_];
#pragma unroll
          for (int tt = 0; tt < 16; ++tt) { int t = qd * 16 + tt; h = sa[t * 64 + e_] * h + sb[t * 64 + e_]; hsum[tt] += h; }
        } else {
#pragma unroll
          for (int q = 3; q >= 0; --q) if (q > qd) h = part[q * 64 + e_] * h + part[(4 + q) * 64 + e_];
#pragma unroll
          for (int tt = 15; tt >= 0; --tt) { int t = qd * 16 + tt; h = sa[t * 64 + e_] * h + sb[t * 64 + e_]; hsum[tt] += h; }
        }
      }
      __syncthreads();
    }
    if (FINAL) {
#pragma unroll
      for (int tt = 0; tt < 16; ++tt) {
        const int t = qd * 16 + tt;
        const float gzv = bf2f(xs[t * 64 + e_]);
        ub[t * 72 + e_] = (u16)f2bf(hsum[tt] * siluf_(gzv));
      }
      __syncthreads();
      u16* ob = p.ACT + (size_t)tb * DM + 256 + nb * 64 + (tid & 7) * 8;
      *(uint4*)(ob + (size_t)(tid >> 3) * DM) = *(const uint4*)(ub + (tid >> 3) * 72 + (tid & 7) * 8);
      *(uint4*)(ob + (size_t)((tid >> 3) + 32) * DM) = *(const uint4*)(ub + ((tid >> 3) + 32) * 72 + (tid & 7) * 8);
    }
  }
  __syncthreads();
}

__device__ void lru_scan_item(const Params& p, int item) {
  const int i = item * 256 + TIDX();
  const int seq = i >> 10, d = (i >> 9) & 1, ch = i & 511;
  int base, len; seq_info(seq, base, len);
  const int c0 = base >> 6, nc = len >> 6;
  float h = 0.f;
  for (int n0 = 0; n0 < nc; n0 += 16) {
    float a[16], b[16];
#pragma unroll
    for (int k = 0; k < 16; ++k) {
      const int n = d ? (nc - 1 - (n0 + k)) : (n0 + k);
      const size_t ix = ((size_t)(c0 + n) * 2 + d) * 512 + ch;
      a[k] = p.CA[ix]; b[k] = p.CB[ix];
    }
#pragma unroll
    for (int k = 0; k < 16; ++k) {
      const int n = d ? (nc - 1 - (n0 + k)) : (n0 + k);
      const size_t ix = ((size_t)(c0 + n) * 2 + d) * 512 + ch;
      p.CB[ix] = h; h = a[k] * h + b[k];
    }
  }
}

__device__ void hgrn_item(const Params& p, int l, int item, unsigned char* smem, bool dry = false) {
  float* LF = (float*)smem;
  u16* KKB = (u16*)(smem + 16384);
  u16* QH = (u16*)(smem + 25600);
  u16* QT = (u16*)(smem + 34816);
  u16* KHT = (u16*)(smem + 44032);
  u16* VTt = (u16*)(smem + 53248);
  u16* ST = (u16*)(smem + 62464);
  float* part = (float*)(smem + 71680);
  const int tid = TIDX(), lane = tid & 63, w = tid >> 6, l15 = lane & 15, g = lane >> 4;
  const int seq = item >> 3, h = (item >> 1) & 3, d = item & 1;
  int base, len; seq_info(seq, base, len);
  const int nc = len >> 6;
  const int r0 = tid >> 3, kc = tid & 7;
  const int cfslot = d ? C_HFB : C_HFF;
  float lbv[8];
#pragma unroll
  for (int e = 0; e < 8; ++e) {
    if (l == 0) lbv[e] = 0.f;
    else {
      float a1 = p.hg_lb[(1 * 2 + d) * 256 + 64 * h + 8 * kc + e], a0 = p.hg_lb[(0 * 2 + d) * 256 + 64 * h + 8 * kc + e];
      lbv[e] = sigmoidf_(a1 - a0);
    }
  }
  __syncthreads();
  for (int i = tid; i < 64 * 72 / 2; i += 256) ((unsigned*)ST)[i] = 0u;
  f32x4 Sacc[4];
#pragma unroll
  for (int vt = 0; vt < 4; ++vt) Sacc[vt] = f32x4{0.f, 0.f, 0.f, 0.f};
  uint4 rq[2], rf[2], rv[2];
#define HG_TOK(n, i) (d ? (base + len - 1 - ((n) * 64 + (i))) : (base + (n) * 64 + (i)))
#pragma unroll
  for (int s = 0; s < 2; ++s) {
    const u16* zr = p.Z + (size_t)HG_TOK(0, r0 + 32 * s) * DIN + 64 * h + 8 * kc;
    rq[s] = *(const uint4*)(zr + C_HQ); { typedef unsigned u4v __attribute__((ext_vector_type(4))); const u4v t_ = __builtin_nontemporal_load((const u4v*)(zr + cfslot)); rf[s] = make_uint4(t_[0], t_[1], t_[2], t_[3]); } rv[s] = *(const uint4*)(zr + C_HI);
  }
  for (int n = 0; n < nc; ++n) {
    float qs[2][8], kk[2][8];
    uint4 vraw[2];
#pragma unroll
    for (int s = 0; s < 2; ++s) {
      const int i = r0 + 32 * s;
      float zf[8], zq[8], lf[8];
      unpack8(rf[s], zf); unpack8(rq[s], zq);
      vraw[s] = rv[s];
#pragma unroll
      for (int e = 0; e < 8; ++e) {
        float sg = sigmoidf_(zf[e]);
        float f = lbv[e] + (1.f - lbv[e]) * sg;
        lf[e] = __logf(f);
        kk[s][e] = (1.f - lbv[e]) * (1.f - sg);
        qs[s][e] = siluf_(zq[e]);
      }
      *(float4*)(LF + i * 64 + 8 * kc) = make_float4(lf[0], lf[1], lf[2], lf[3]);
      *(float4*)(LF + i * 64 + 8 * kc + 4) = make_float4(lf[4], lf[5], lf[6], lf[7]);
      *(uint4*)(KKB + i * 72 + 8 * kc) = pack8(kk[s]);
    }
    if (n + 1 < nc) {
#pragma unroll
      for (int s = 0; s < 2; ++s) {
        const u16* zr = p.Z + (size_t)HG_TOK(n + 1, r0 + 32 * s) * DIN + 64 * h + 8 * kc;
        rq[s] = *(const uint4*)(zr + C_HQ); { typedef unsigned u4v __attribute__((ext_vector_type(4))); const u4v t_ = __builtin_nontemporal_load((const u4v*)(zr + cfslot)); rf[s] = make_uint4(t_[0], t_[1], t_[2], t_[3]); } rv[s] = *(const uint4*)(zr + C_HI);
      }
    }
    __syncthreads();
    {
      const int k = tid & 63, qd = tid >> 6;
      float s = 0.f;
#pragma unroll
      for (int tt = 0; tt < 16; ++tt) { int i = qd * 16 + tt; s += LF[i * 64 + k]; LF[i * 64 + k] = s; }
      part[qd * 64 + k] = s;
    }
    __syncthreads();
    {
      const int k = tid & 63, qd = tid >> 6;
      float off = 0.f;
#pragma unroll
      for (int q = 0; q < 3; ++q) if (q < qd) off += part[q * 64 + k];
      if (qd > 0) {
#pragma unroll
        for (int tt = 0; tt < 16; ++tt) { int i = qd * 16 + tt; LF[i * 64 + k] += off; }
      }
    }
    __syncthreads();
#pragma unroll
    for (int s = 0; s < 2; ++s) {
      const int i = r0 + 32 * s, I = i >> 4;
      float c8[8], cl8[8], cp8[8], qh[8], qt[8], vv[8];
      *(float4*)(c8) = *(const float4*)(LF + i * 64 + 8 * kc); *(float4*)(c8 + 4) = *(const float4*)(LF + i * 64 + 8 * kc + 4);
      *(float4*)(cl8) = *(const float4*)(LF + 63 * 64 + 8 * kc); *(float4*)(cl8 + 4) = *(const float4*)(LF + 63 * 64 + 8 * kc + 4);
      if (I > 0) {
        *(float4*)(cp8) = *(const float4*)(LF + (16 * I - 1) * 64 + 8 * kc); *(float4*)(cp8 + 4) = *(const float4*)(LF + (16 * I - 1) * 64 + 8 * kc + 4);
      } else {
#pragma unroll
        for (int e = 0; e < 8; ++e) cp8[e] = 0.f;
      }
      unpack8(vraw[s], vv);
#pragma unroll
      for (int e = 0; e < 8; ++e) {
        qt[e] = qs[s][e] * __expf(c8[e] - cp8[e]);
        qh[e] = qs[s][e] * __expf(c8[e]);
        KHT[(8 * kc + e) * 72 + i] = (u16)f2bf(kk[s][e] * __expf(cl8[e] - c8[e]));
        VTt[(8 * kc + e) * 72 + i] = (u16)f2bf(vv[e]);
      }
      *(uint4*)(QH + i * 72 + 8 * kc) = pack8(qh);
      *(uint4*)(QT + i * 72 + 8 * kc) = pack8(qt);
    }
    __syncthreads();
    float clw[4];
    {
      const int I = w;
      float cpI[2][8];
#pragma unroll
      for (int ks = 0; ks < 2; ++ks)
#pragma unroll
        for (int e = 0; e < 8; ++e) cpI[ks][e] = (I > 0) ? LF[(16 * I - 1) * 64 + 32 * ks + 8 * g + e] : 0.f;
#pragma unroll
      for (int j = 0; j < 4; ++j) clw[j] = LF[63 * 64 + 16 * w + 4 * g + j];
      f32x4 acc[4];
#pragma unroll
      for (int vt = 0; vt < 4; ++vt) acc[vt] = f32x4{0.f, 0.f, 0.f, 0.f};
      bf16x8 qtf[2];
#pragma unroll
      for (int ks = 0; ks < 2; ++ks) {
        bf16x8 qhf = *(const bf16x8*)(QH + (16 * I + l15) * 72 + 32 * ks + 8 * g);
        qtf[ks] = *(const bf16x8*)(QT + (16 * I + l15) * 72 + 32 * ks + 8 * g);
#pragma unroll
        for (int vt = 0; vt < 4; ++vt) {
          bf16x8 stf = *(const bf16x8*)(ST + (16 * vt + l15) * 72 + 32 * ks + 8 * g);
          acc[vt] = mfma16(stf, qhf, acc[vt]);
        }
      }
      unsigned pk[2][4];
#pragma unroll
      for (int a = 0; a < 2; ++a)
#pragma unroll
        for (int b = 0; b < 4; ++b) pk[a][b] = 0u;
#pragma unroll
      for (int J = 0; J < 4; ++J) {
        if (J <= I) {
          f32x4 sT = {0.f, 0.f, 0.f, 0.f};
#pragma unroll
          for (int ks = 0; ks < 2; ++ks) {
            uint4 kraw = *(const uint4*)(KKB + (16 * J + l15) * 72 + 32 * ks + 8 * g);
            float kx[8], cj[8];
            unpack8(kraw, kx);
            *(float4*)(cj) = *(const float4*)(LF + (16 * J + l15) * 64 + 32 * ks + 8 * g);
            *(float4*)(cj + 4) = *(const float4*)(LF + (16 * J + l15) * 64 + 32 * ks + 8 * g + 4);
#pragma unroll
            for (int e = 0; e < 8; ++e) kx[e] *= __expf(cpI[ks][e] - cj[e]);
            uint4 kf = pack8(kx);
            sT = mfma16(as_bf8(kf), qtf[ks], sT);
          }
          if (J == I) {
#pragma unroll
            for (int j = 0; j < 4; ++j) if (4 * g + j > l15) sT[j] = 0.f;
          }
          pk[J >> 1][(J & 1) * 2 + 0] = pack2(sT[0], sT[1]);
          pk[J >> 1][(J & 1) * 2 + 1] = pack2(sT[2], sT[3]);
        }
      }
#pragma unroll
      for (int kp = 0; kp < 2; ++kp) {
        if (kp <= (I >> 1)) {
          uint4 pv = make_uint4(pk[kp][0], pk[kp][1], pk[kp][2], pk[kp][3]);
#pragma unroll
          for (int vt = 0; vt < 4; ++vt) {
            uint2 a = *(const uint2*)(VTt + (16 * vt + l15) * 72 + 32 * kp + 4 * g);
            uint2 b = *(const uint2*)(VTt + (16 * vt + l15) * 72 + 32 * kp + 16 + 4 * g);
            uint4 vf = make_uint4(a.x, a.y, b.x, b.y);
            acc[vt] = mfma16(as_bf8(vf), as_bf8(pv), acc[vt]);
          }
        }
      }
      u16* orow = dry ? (p.ACT + (size_t)HG_TOK(n, 16 * I + l15) * DM + 64 * h) : (p.Z + (size_t)HG_TOK(n, 16 * I + l15) * DIN + cfslot + 64 * h);
#pragma unroll
      for (int vt = 0; vt < 4; ++vt) {
        uint2 o2; o2.x = pack2(acc[vt][0], acc[vt][1]); o2.y = pack2(acc[vt][2], acc[vt][3]);
        *(uint2*)(orow + 16 * vt + 4 * g) = o2;
      }
    }
    __syncthreads();
    {
      float dec[4];
#pragma unroll
      for (int j = 0; j < 4; ++j) dec[j] = __expf(clw[j]);
#pragma unroll
      for (int vt = 0; vt < 4; ++vt)
#pragma unroll
        for (int j = 0; j < 4; ++j) Sacc[vt][j] *= dec[j];
#pragma unroll
      for (int ks = 0; ks < 2; ++ks) {
        bf16x8 khf = *(const bf16x8*)(KHT + (16 * w + l15) * 72 + 32 * ks + 8 * g);
#pragma unroll
        for (int vt = 0; vt < 4; ++vt) {
          bf16x8 vtf = *(const bf16x8*)(VTt + (16 * vt + l15) * 72 + 32 * ks + 8 * g);
          Sacc[vt] = mfma16(khf, vtf, Sacc[vt]);
        }
      }
#pragma unroll
      for (int vt = 0; vt < 4; ++vt) {
        uint2 o2; o2.x = pack2(Sacc[vt][0], Sacc[vt][1]); o2.y = pack2(Sacc[vt][2], Sacc[vt][3]);
        *(uint2*)(ST + (16 * vt + l15) * 72 + 16 * w + 4 * g) = o2;
      }
    }
  }
#undef HG_TOK
  __syncthreads();
}

__device__ void phase_hgrn_combine(const Params& p, int l) {
  const int lane = TIDX() & 63;
  const int gw = BIDX() * 4 + (TIDX() >> 6), nw = gridDim.x * 4;
  const int hd = lane >> 4, sub = lane & 15;
  const float4 gn = *(const float4*)(p.hg_norm + l * 64 + 4 * sub);
  for (int t = gw; t < T_TOK; t += nw) {
    const u16* zr = p.Z + (size_t)t * DIN + 64 * hd + 4 * sub;
    typedef unsigned u2v __attribute__((ext_vector_type(2)));
    const u2v a_ = __builtin_nontemporal_load((const u2v*)(zr + C_HFF)), b_ = __builtin_nontemporal_load((const u2v*)(zr + C_HFB)),
              g_ = __builtin_nontemporal_load((const u2v*)(zr + C_HG));
    uint2 a = make_uint2(a_[0], a_[1]), b = make_uint2(b_[0], b_[1]), gz = make_uint2(g_[0], g_[1]);
    float o0 = lo_f(a.x) + lo_f(b.x), o1 = hi_f(a.x) + hi_f(b.x), o2 = lo_f(a.y) + lo_f(b.y), o3 = hi_f(a.y) + hi_f(b.y);
    float ss = o0 * o0 + o1 * o1 + o2 * o2 + o3 * o3;
#pragma unroll
    for (int o = 8; o >= 1; o >>= 1) ss += __shfl_xor(ss, o);
    float rs = rsqrtf(ss * (1.0f / 64.0f) + RMS_EPS);
    uint2 r;
    r.x = pack2_hw(o0 * rs * gn.x * siluf_(lo_f(gz.x)), o1 * rs * gn.y * siluf_(hi_f(gz.x)));
    r.y = pack2_hw(o2 * rs * gn.z * siluf_(lo_f(gz.y)), o3 * rs * gn.w * siluf_(hi_f(gz.y)));
    *(uint2*)(p.ACT + (size_t)t * DM + 64 * hd + 4 * sub) = r;
  }
}

__device__ void attn_item(const Params& p, int l, int item, unsigned char* smem) {
  const int tid = TIDX(), lane = tid & 63, w = tid >> 6, l15 = lane & 15, g = lane >> 4;
  int seq, h, qb;
  if (item < 2048) { seq = item >> 7; h = (item >> 5) & 3; qb = item & 31; }
  else { int id = item - 2048; seq = 16 + (id >> 6); h = (id >> 4) & 3; qb = id & 15; }
  int tb, len; seq_info(seq, tb, len);
  const int q0 = qb * 128 + 32 * w;
  const float SC = 0.17677669529663687f * 1.4426950408889634f;
  bf16x8 Qf[2][2];
  float cref[2][2];
#pragma unroll
  for (int hh = 0; hh < 2; ++hh)
#pragma unroll
    for (int qt = 0; qt < 2; ++qt) {
      const int qpos = q0 + 16 * qt + l15;
      uint4 raw = *(const uint4*)(p.Z + (size_t)(tb + qpos) * DIN + C_DQ + (2 * h + hh) * 32 + 8 * g);
      float x[8], y[8]; unpack8(raw, x);
      if (g == 0) {
        const float* rt = p.ROPE + (size_t)qpos * 8;
#pragma unroll
        for (int k = 0; k < 4; ++k) {
          float c = rt[2 * k], s = rt[2 * k + 1];
          y[k] = x[k] * c - x[k + 4] * s;
          y[k + 4] = x[k + 4] * c + x[k] * s;
        }
      } else {
#pragma unroll
        for (int k = 0; k < 8; ++k) y[k] = x[k];
      }
      float q2 = 0.f;
#pragma unroll
      for (int k = 0; k < 8; ++k) { y[k] *= SC; q2 += y[k] * y[k]; }
      q2 += __shfl_xor(q2, 16); q2 += __shfl_xor(q2, 32);
      cref[hh][qt] = sqrtf(q2 * __uint_as_float(p.KMAX[(l * 32 + seq) * 8 + 2 * h + hh])) * 1.02f;
      Qf[hh][qt] = as_bf8(pack8(y));
    }
  const bool fixedref = (__builtin_amdgcn_ballot_w64(fmaxf(fmaxf(cref[0][0], cref[0][1]), fmaxf(cref[1][0], cref[1][1])) > 40.0f) == 0);
  f32x4 O[2][4][2];
  float mrun[2][2];
  f32x4 Ol[2][2];
  const bf16x8 ones8 = as_bf8(make_uint4(0x3F803F80u, 0x3F803F80u, 0x3F803F80u, 0x3F803F80u));
#pragma unroll
  for (int hh = 0; hh < 2; ++hh)
#pragma unroll
    for (int qt = 0; qt < 2; ++qt) {
      mrun[hh][qt] = fixedref ? cref[hh][qt] : 0.f; Ol[hh][qt] = f32x4{0.f, 0.f, 0.f, 0.f};
#pragma unroll
      for (int dt = 0; dt < 4; ++dt) O[hh][dt][qt] = f32x4{0.f, 0.f, 0.f, 0.f};
    }
  const int nkt = len >> 6;
  const int srow = tid >> 3, sch = (tid & 7) * 8;
  const u16* gk = p.Z + (size_t)(tb + srow) * DIN + C_DK + 64 * h + sch;
  const u16* gv = p.VT + (size_t)(64 * h + srow) * T_TOK + tb + sch;
  u16* sbase = (u16*)smem;
  uint4 rk0, rk1, rv0, rv1;
  __syncthreads();
  rk0 = *(const uint4*)(gk);
  rk1 = *(const uint4*)(gk + (size_t)32 * DIN);
  rv0 = *(const uint4*)(gv);
  rv1 = *(const uint4*)(gv + (size_t)32 * T_TOK);
  *(uint4*)(sbase + srow * 72 + sch) = rk0;
  *(uint4*)(sbase + (srow + 32) * 72 + sch) = rk1;
  *(uint4*)(sbase + 64 * 72 + srow * 72 + sch) = rv0;
  *(uint4*)(sbase + 64 * 72 + (srow + 32) * 72 + sch) = rv1;
  __syncthreads();
  for (int kt = 0; kt < nkt; ++kt) {
    const int cur = kt & 1;
    const bool more = (kt + 1 < nkt);
    if (more) {
      rk0 = *(const uint4*)(gk + (size_t)((kt + 1) * 64) * DIN);
      rk1 = *(const uint4*)(gk + (size_t)((kt + 1) * 64 + 32) * DIN);
      rv0 = *(const uint4*)(gv + (kt + 1) * 64);
      rv1 = *(const uint4*)(gv + (size_t)32 * T_TOK + (kt + 1) * 64);
    }
    __builtin_amdgcn_sched_barrier(0);
    const u16* KS = sbase + cur * (2 * 64 * 72);
    const u16* VS = KS + 64 * 72;
#pragma unroll
    for (int hh = 0; hh < 2; ++hh) {
      bf16x8 Pf[2][2];
      f32x4 st[4][2];
      {
        f32x4 ci0, ci1;
        ci0[0] = ci0[1] = ci0[2] = ci0[3] = -mrun[hh][0];
        ci1[0] = ci1[1] = ci1[2] = ci1[3] = -mrun[hh][1];
#pragma unroll
        for (int k4 = 0; k4 < 4; ++k4) {
          bf16x8 kf = *(const bf16x8*)(KS + (16 * k4 + l15) * 72 + 32 * hh + 8 * g);
          st[k4][0] = mfma16(kf, Qf[hh][0], ci0);
          st[k4][1] = mfma16(kf, Qf[hh][1], ci1);
        }
      }
      __builtin_amdgcn_sched_barrier(0);
      if (!fixedref) {
      float mx[2];
#pragma unroll
      for (int qt = 0; qt < 2; ++qt) {
        float m_ = st[0][qt][0];
#pragma unroll
        for (int k4 = 0; k4 < 4; ++k4)
#pragma unroll
          for (int j = 0; j < 4; ++j) m_ = fmaxf(m_, st[k4][qt][j]);
        m_ = fmaxf(m_, __shfl_xor(m_, 16));
        m_ = fmaxf(m_, __shfl_xor(m_, 32));
        mx[qt] = m_;
      }
      const bool upd = (kt == 0) || (__builtin_amdgcn_ballot_w64(fmaxf(mx[0], mx[1]) > 8.0f) != 0);
      if (upd) {
#pragma unroll
        for (int qt = 0; qt < 2; ++qt) {
          const float delta = (kt == 0 || mx[qt] > 8.0f) ? mx[qt] : 0.f;
          mrun[hh][qt] += delta;
          const float alpha = __builtin_amdgcn_exp2f(-delta);
#pragma unroll
          for (int j = 0; j < 4; ++j) Ol[hh][qt][j] *= alpha;
#pragma unroll
          for (int dt = 0; dt < 4; ++dt)
#pragma unroll
            for (int j = 0; j < 4; ++j) O[hh][dt][qt][j] *= alpha;
#pragma unroll
          for (int k4 = 0; k4 < 4; ++k4)
#pragma unroll
            for (int j = 0; j < 4; ++j) st[k4][qt][j] -= delta;
        }
      }
      }
#pragma unroll
      for (int qt = 0; qt < 2; ++qt) {
#pragma unroll
        for (int k4 = 0; k4 < 4; ++k4)
#pragma unroll
          for (int j = 0; j < 4; ++j) st[k4][qt][j] = __builtin_amdgcn_exp2f(st[k4][qt][j]);
#pragma unroll
        for (int ks = 0; ks < 2; ++ks) {
          uint4 pk;
          pk.x = pack2_hw(st[2 * ks][qt][0], st[2 * ks][qt][1]); pk.y = pack2_hw(st[2 * ks][qt][2], st[2 * ks][qt][3]);
          pk.z = pack2_hw(st[2 * ks + 1][qt][0], st[2 * ks + 1][qt][1]); pk.w = pack2_hw(st[2 * ks + 1][qt][2], st[2 * ks + 1][qt][3]);
          Pf[qt][ks] = as_bf8(pk);
          Ol[hh][qt] = mfma16(ones8, Pf[qt][ks], Ol[hh][qt]);
        }
        __builtin_amdgcn_sched_barrier(0);
      }
#pragma unroll
    for (int dt = 0; dt < 4; ++dt) {
      bf16x8 Vf[2];
#pragma unroll
      for (int ks = 0; ks < 2; ++ks) {
        uint2 a = *(const uint2*)(VS + (16 * dt + l15) * 72 + 32 * ks + 4 * g);
        uint2 b = *(const uint2*)(VS + (16 * dt + l15) * 72 + 32 * ks + 16 + 4 * g);
        Vf[ks] = as_bf8(make_uint4(a.x, a.y, b.x, b.y));
      }
#pragma unroll
        for (int qt = 0; qt < 2; ++qt)
#pragma unroll
          for (int ks = 0; ks < 2; ++ks) O[hh][dt][qt] = mfma16(Vf[ks], Pf[qt][ks], O[hh][dt][qt]);
    }
    }
    __builtin_amdgcn_sched_barrier(0);
    if (more) {
      u16* nb_ = sbase + (cur ^ 1) * (2 * 64 * 72);
      *(uint4*)(nb_ + srow * 72 + sch) = rk0;
      *(uint4*)(nb_ + (srow + 32) * 72 + sch) = rk1;
      *(uint4*)(nb_ + 64 * 72 + srow * 72 + sch) = rv0;
      *(uint4*)(nb_ + 64 * 72 + (srow + 32) * 72 + sch) = rv1;
    }
    __syncthreads();
  }
  float s1 = 0.f, s2 = 0.f;
  for (int k = 0; k < 32; ++k) { s1 += p.lq1[l * 32 + k] * p.lk1[l * 32 + k]; s2 += p.lq2[l * 32 + k] * p.lk2[l * 32 + k]; }
  const float lam_init = (l == 0) ? 0.2f : (0.8f - 0.6f * 0.74081822068171788f);
  const float lam = __expf(s1) - __expf(s2) + lam_init;
#pragma unroll
  for (int qt = 0; qt < 2; ++qt) {
    const float l0 = Ol[0][qt][0], l1 = Ol[1][qt][0];
    const float i0 = 1.0f / l0, i1 = lam / l1;
    float o[4][4];
    float ss = 0.f;
#pragma unroll
    for (int dt = 0; dt < 4; ++dt)
#pragma unroll
      for (int j = 0; j < 4; ++j) { o[dt][j] = O[0][dt][qt][j] * i0 - O[1][dt][qt][j] * i1; ss += o[dt][j] * o[dt][j]; }
    ss += __shfl_xor(ss, 16); ss += __shfl_xor(ss, 32);
    const float rs = rsqrtf(ss * (1.0f / 64.0f) + RMS_EPS) * (1.0f - lam_init);
    const int t = tb + q0 + 16 * qt + l15;
#pragma unroll
    for (int dt = 0; dt < 4; ++dt) {
      const int dd = 16 * dt + 4 * g;
      uint2 gz = *(const uint2*)(p.Z + (size_t)t * DIN + C_DG + 64 * h + dd);
      float4 gn = *(const float4*)(p.da_norm + l * 64 + dd);
      uint2 r;
      r.x = pack2_hw(o[dt][0] * rs * gn.x * siluf_(lo_f(gz.x)), o[dt][1] * rs * gn.y * siluf_(hi_f(gz.x)));
      r.y = pack2_hw(o[dt][2] * rs * gn.z * siluf_(lo_f(gz.y)), o[dt][3] * rs * gn.w * siluf_(hi_f(gz.y)));
      *(uint2*)(p.ACT + (size_t)t * DM + 768 + 64 * h + dd) = r;
    }
  }
}

__device__ void run_phase(const Params& p, int ph, unsigned char* smem) {
  if (ph == 0) { phase_prep(p, smem); return; }
  if (ph == NPHASE - 1) { phase_norm(p, 0, true); return; }
  const int l = (ph - 1) / 7, s = (ph - 1) % 7;
  switch (s) {
    case 0: phase_norm(p, l, false); break;
    case 1: phase_gemm_in(p, l, smem);
#if PROBE_DUP == 1
      phase_gemm_in(p, l, smem);
#endif
      break;
    case 2:
      phase_krope(p, l);
      phase_lru<false>(p, l, smem);
      break;
    case 3: {
      int* slot = (int*)(smem + 73728);
      for (;;) {
        __syncthreads();
        if (TIDX() == 0) *slot = (int)atomicAdd(p.CTR + l, 1u);
        __syncthreads();
        const int it = *slot;
#if PROBE_DUP == 4
        if (it >= 256 + 128 + 3072 * 2) break;
#else
        if (it >= 256 + 128 + 3072) break;
#endif
        if (it < 256) hgrn_item(p, l, it, smem);
        else if (it < 256 + 3072) attn_item(p, l, it - 256, smem);
        else lru_scan_item(p, it - 256 - 3072);
      }
      break;
    }
    case 4:
      phase_lru<true>(p, l, smem);
      phase_hgrn_combine(p, l);
#if PROBE_DUP == 5
      phase_lru<true>(p, l, smem);
#endif
#if PROBE_DUP == 15
      phase_hgrn_combine(p, l);
      phase_hgrn_combine(p, l);
      phase_hgrn_combine(p, l);
      phase_hgrn_combine(p, l);
#endif
      break;
    case 5: phase_gemm_out(p, l, smem); break;
    case 6: phase_gemm_ple(p, l, smem); break;
  }
}


#define XB_TMO      128
#define XB_XCNT(j)  (256  + 64 * (j))
#define XB_XSUB(j)  (1280 + 64 * (j))
#define XB_XGEN(j)  (2304 + 64 * (j))
#define XB_TOP      3328
#define XB_TOPGEN   3392
#define XCD_BAR_WORDS 3456
#define XB_SPIN_CAP (1u << 18)
#define LAS __attribute__((address_space(3)))
__device__ __forceinline__ unsigned xb_ld(unsigned* p)              { return __hip_atomic_load(p, __ATOMIC_RELAXED, __HIP_MEMORY_SCOPE_AGENT); }
__device__ __forceinline__ unsigned xb_add(unsigned* p, unsigned v) { return __hip_atomic_fetch_add(p, v, __ATOMIC_RELAXED, __HIP_MEMORY_SCOPE_AGENT); }
__device__ __forceinline__ unsigned xb_xcc_id() { return (unsigned)__builtin_amdgcn_s_getreg((3 << 11) | 20) & 0xFu; }
#define XB_SPIN(cond, bar) do { unsigned _sp = 0; while (cond) { __builtin_amdgcn_s_sleep(1); \
    if ((++_sp & 255u) == 0u) { if (xb_ld(&(bar)[XB_TMO])) break; if (_sp > XB_SPIN_CAP) { atomicAdd(&(bar)[XB_TMO], 1u); break; } } } } while (0)
struct XcdBarrier { unsigned* bar; unsigned x; volatile LAS unsigned* st; };
__device__ __forceinline__ XcdBarrier xcd_barrier_post(unsigned* bar, volatile LAS unsigned* st) {
  XcdBarrier b; b.bar = bar; b.x = xb_xcc_id(); b.st = st;
  if (threadIdx.x == 0) (void)xb_add(&bar[XB_XCNT(b.x)], 1u);
  return b;
}
__device__ __forceinline__ void xcd_barrier_complete(unsigned* bar, unsigned x, unsigned& nloc, unsigned& nx) {
  const unsigned G = gridDim.x * gridDim.y * gridDim.z;
  unsigned sum, cnt, mine, sp = 0u;
  for (;;) {
    sum = 0u; cnt = 0u; mine = 0u;
#pragma unroll
    for (unsigned j = 0; j < 16; ++j) { const unsigned c = xb_ld(&bar[XB_XCNT(j)]); sum += c; cnt += (c > 0u) ? 1u : 0u; mine = (j == x) ? c : mine; }
    if (sum == G) break;
    __builtin_amdgcn_s_sleep(1);
    if ((++sp & 255u) == 0u) { if (xb_ld(&bar[XB_TMO])) break; if (sp > XB_SPIN_CAP) { atomicAdd(&bar[XB_TMO], 1u); break; } }
  }
  nloc = mine > 0u ? mine : 1u; nx = cnt > 0u ? cnt : 1u;
}
__device__ __forceinline__ void xcd_barrier(const XcdBarrier& b) {
  asm volatile("s_waitcnt vmcnt(0)" ::: "memory");
  __syncthreads();
  if (threadIdx.x == 0) {
    unsigned* bar = b.bar;
    __builtin_amdgcn_s_waitcnt(0);
    unsigned nloc = b.st[0], nx = b.st[1];
    if (nloc == 0u) { xcd_barrier_complete(bar, b.x, nloc, nx); b.st[0] = nloc; b.st[1] = nx; }
    const unsigned old = xb_add(&bar[XB_XSUB(b.x)], 1u);
    const unsigned gen = old / nloc;
    if (old + 1u == (gen + 1u) * nloc) {
      __builtin_amdgcn_fence(__ATOMIC_RELEASE, "agent");
      asm volatile("s_waitcnt vmcnt(0)" ::: "memory");
      const unsigned og = xb_add(&bar[XB_TOP], 1u);
      const unsigned tg = og / nx;
      if (og + 1u == (tg + 1u) * nx) xb_add(&bar[XB_TOPGEN], 1u);
      else XB_SPIN(xb_ld(&bar[XB_TOPGEN]) == tg, bar);
      __builtin_amdgcn_fence(__ATOMIC_ACQUIRE, "agent");
      xb_add(&bar[XB_XGEN(b.x)], 1u);
      asm volatile("s_waitcnt vmcnt(0)" ::: "memory");
    } else {
      XB_SPIN(xb_ld(&bar[XB_XGEN(b.x)]) == gen, bar);
      __builtin_amdgcn_fence(__ATOMIC_ACQUIRE, "agent");
      asm volatile("s_waitcnt vmcnt(0)" ::: "memory");
    }
  }
  __syncthreads();
}

__global__ void __launch_bounds__(256, 2) mega(Params p) {
  extern __shared__ __attribute__((aligned(16))) unsigned char smem[];
  cg::grid_group grid = cg::this_grid();
  const bool multi = (p.phase_hi - p.phase_lo) > 1;
  XcdBarrier xb; xb.bar = p.BAR; xb.x = 0; xb.st = (volatile LAS unsigned*)(smem + 73736);
  if (multi) {
    if (threadIdx.x == 0) { xb.st[0] = 0u; xb.st[1] = 0u; }
    __syncthreads();
    xb = xcd_barrier_post(p.BAR, xb.st);
  }
  for (int ph = p.phase_lo; ph < p.phase_hi; ++ph) {
    if (ph > p.phase_lo) {
      if (ph == p.phase_lo + 1) grid.sync();
      else xcd_barrier(xb);
    }
    run_phase(p, ph, smem);
  }
}

extern "C" void kernel_launch(void* const* d_in, const int* in_sizes, int n_in, void* d_out, int out_size,
                              void* d_ws, size_t ws_size, hipStream_t stream) {
  static int grid_blocks = 0;
  if (!grid_blocks) {
    int dev = 0, cus = 0, per_cu = 0;
    hipGetDevice(&dev);
    hipDeviceGetAttribute(&cus, hipDeviceAttributeMultiprocessorCount, dev);
    hipFuncSetAttribute((const void*)mega, hipFuncAttributeMaxDynamicSharedMemorySize, LDS_BYTES);
    hipOccupancyMaxActiveBlocksPerMultiprocessor(&per_cu, (const void*)mega, 256, LDS_BYTES);
    if (per_cu < 1) per_cu = 1;
    if (per_cu > 2) per_cu = 2;
    grid_blocks = cus * per_cu;
  }
  Params p{};
  const float** fp = (const float**)&p;
  for (int i = 0; i < 24; ++i) fp[i] = (const float*)d_in[i];
  p.out = (float*)d_out;
  unsigned char* ws = (unsigned char*)d_ws;
  size_t off = 0;
  auto take = [&](size_t bytes) { unsigned char* r = ws + off; off += (bytes + 255) & ~(size_t)255; return r; };
  p.Z = (u16*)take((size_t)T_TOK * DIN * 2);
  p.ACT = (u16*)take((size_t)T_TOK * DM * 2);
  p.VT = (u16*)take((size_t)256 * T_TOK * 2);
  p.PB = (u16*)take((size_t)T_TOK * 256 * 2);
  p.CA = (float*)take((size_t)NCHUNK * 2 * 512 * 4);
  p.CB = (float*)take((size_t)NCHUNK * 2 * 512 * 4);
  p.WIN = (u16*)take((size_t)2 * DIN * DM * 2);
  p.WOUT = (u16*)take((size_t)2 * DM * DM * 2);
  p.WGATE = (u16*)take((size_t)2 * DM * DM * 2);
  p.WPLE = (u16*)take((size_t)2 * DM * 256 * 2);
  p.WLRU = (u16*)take((size_t)2 * 2 * 2 * 8 * 4096 * 2);
  p.ROPE = (float*)take((size_t)4096 * 8 * 4);
  p.SP8 = (float*)take((size_t)2 * 2 * 512 * 4);
  p.CTR = (unsigned*)take(256);
  p.KMAX = (unsigned*)take(2 * 256 * 4);
  p.BAR = (unsigned*)take((size_t)XCD_BAR_WORDS * 4);
  if (off > ws_size) { fprintf(stderr, "workspace too small: need %zu have %zu\n", off, ws_size); return; }
#if COOP
  p.phase_lo = 0; p.phase_hi = NPHASE;
  (void)hipMemsetAsync(p.BAR, 0, (size_t)XCD_BAR_WORDS * 4, stream);
  void* args[] = {&p};
  hipError_t e = hipLaunchCooperativeKernel((const void*)mega, dim3(grid_blocks), dim3(256), args, LDS_BYTES, stream);
  if (e != hipSuccess) fprintf(stderr, "cooperative launch failed: %s (grid %d)\n", hipGetErrorString(e), grid_blocks);
#else
  for (int ph = 0; ph < NPHASE; ++ph) {
    p.phase_lo = ph; p.phase_hi = ph + 1;
    hipLaunchKernelGGL(mega, dim3(grid_blocks), dim3(256), LDS_BYTES, stream, p);
  }
#endif
}
```
